# Optimizing an MI355X kernel written in HIP

```python
import jax, jax.numpy as jnp
from jax import lax
import numpy as np

D_MODEL = 4096
BATCH = 2
SEQ = 8192
DEPTH = 2

N_HEADS = 16
QK_NOPE_DIM = 128
QK_ROPE_DIM = 64
V_HEAD_DIM = 128
Q_LORA_RANK = 896
KV_LORA_RANK = 512
MLA_WIDTH = N_HEADS * V_HEAD_DIM
ATTN_SCALE = (QK_NOPE_DIM + QK_ROPE_DIM) ** -0.5
ROPE_THETA = 10000.0
Q_BLOCK = 128

POOL_WINDOWS = (2, 4, 8, 16)
POOL_GROUPS = len(POOL_WINDOWS)
POOL_WIDTH = D_MODEL - MLA_WIDTH
POOL_GROUP_DIM = POOL_WIDTH // POOL_GROUPS

MIX_WIDTH = MLA_WIDTH + POOL_WIDTH
IN_DIM = Q_LORA_RANK + KV_LORA_RANK + QK_ROPE_DIM + POOL_WIDTH

D_FF = -(-8 * D_MODEL // (3 * 256)) * 256
NORM_EPS = 1e-6

kernel_name = "hybrid_mla_multiscale_pool_sandwich"


def rmsnorm(x, g):
    xf = x.astype(jnp.float32)
    y = xf * lax.rsqrt(jnp.mean(xf * xf, axis=-1, keepdims=True) + NORM_EPS)
    return y.astype(x.dtype) * g


def rope_tables(positions, dtype):
    inv_freq = ROPE_THETA ** (-jnp.arange(0, QK_ROPE_DIM, 2, dtype=jnp.float32) / QK_ROPE_DIM)
    ang = positions.astype(jnp.float32)[..., None] * inv_freq
    return jnp.cos(ang).astype(dtype), jnp.sin(ang).astype(dtype)


def apply_rope(t, cos, sin):
    half = QK_ROPE_DIM // 2
    t1, t2 = t[..., :half], t[..., half:]
    return jnp.concatenate([t1 * cos - t2 * sin, t2 * cos + t1 * sin], axis=-1)


def causal_mla_attention(q_nope, q_rope, k_nope, k_rope, v):
    B, S, H, _ = q_nope.shape
    nb = S // Q_BLOCK
    k_idx = jnp.arange(S)

    def to_blocks(t):
        return t.reshape(B, nb, Q_BLOCK, *t.shape[2:]).swapaxes(0, 1)

    def block(args):
        qn, qr, start = args
        s = (jnp.einsum('bqhd,bkhd->bhqk', qn, k_nope, preferred_element_type=jnp.float32)
             + jnp.einsum('bqhr,bkr->bhqk', qr, k_rope, preferred_element_type=jnp.float32)) * ATTN_SCALE
        q_idx = start + jnp.arange(Q_BLOCK)
        mask = k_idx[None, :] <= q_idx[:, None]
        p = jax.nn.softmax(jnp.where(mask, s, -jnp.inf), axis=-1)
        return jnp.einsum('bhqk,bkhd->bqhd', p.astype(v.dtype), v)

    out = lax.map(block, (to_blocks(q_nope), to_blocks(q_rope), jnp.arange(nb) * Q_BLOCK))
    return out.swapaxes(0, 1).reshape(B, S, H, V_HEAD_DIM)


def multiscale_pool(u, pool_w, pool_scale):
    B, S, _ = u.shape
    groups = u.astype(jnp.float32).reshape(B, S, POOL_GROUPS, POOL_GROUP_DIM)
    cs = jnp.cumsum(groups, axis=1)
    t = jnp.arange(S)
    diffs = []
    for g, w in enumerate(POOL_WINDOWS):
        c = cs[:, :, g]
        lag = jnp.pad(c, ((0, 0), (w, 0), (0, 0)))[:, :S]
        cnt = jnp.minimum(t + 1, w).astype(jnp.float32)[None, :, None]
        diffs.append((c - lag) / cnt - groups[:, :, g])
    d = jnp.stack(diffs, axis=2).astype(u.dtype)
    y = jnp.einsum('bsgc,gcd->bsgd', d, pool_w).reshape(B, S, POOL_WIDTH)
    return y * pool_scale


def hybrid_mixer(a, cos, sin, w_in, q_norm, w_q_up, kv_norm, w_kv_up, pool_w, pool_scale, w_out):
    B, S, _ = a.shape
    z = a @ w_in
    o1 = Q_LORA_RANK
    o2 = o1 + KV_LORA_RANK
    o3 = o2 + QK_ROPE_DIM
    c_q, c_kv, k_rope, u = z[..., :o1], z[..., o1:o2], z[..., o2:o3], z[..., o3:]
    q = (rmsnorm(c_q, q_norm) @ w_q_up).reshape(B, S, N_HEADS, QK_NOPE_DIM + QK_ROPE_DIM)
    q_nope = q[..., :QK_NOPE_DIM]
    q_rope = apply_rope(q[..., QK_NOPE_DIM:], cos[:, :, None, :], sin[:, :, None, :])
    k_rope = apply_rope(k_rope, cos, sin)
    kv = (rmsnorm(c_kv, kv_norm) @ w_kv_up).reshape(B, S, N_HEADS, QK_NOPE_DIM + V_HEAD_DIM)
    k_nope, v = kv[..., :QK_NOPE_DIM], kv[..., QK_NOPE_DIM:]
    attn = causal_mla_attention(q_nope, q_rope, k_nope, k_rope, v).reshape(B, S, MLA_WIDTH)
    pool = multiscale_pool(u, pool_w, pool_scale)
    return jnp.concatenate([attn, pool], axis=-1) @ w_out


def swiglu(h, w_gate, w_up, w_down):
    return (jax.nn.silu(h @ w_gate) * (h @ w_up)) @ w_down


def setup_inputs(seed: int = 0) -> dict:
    key = jax.random.key(seed)
    ks = jax.random.split(key, 20)

    def w(k, shape, fan_in):
        return jax.random.normal(k, shape, jnp.float32) * fan_in ** -0.5

    def gain(k, shape):
        return 1.0 + 0.02 * jax.random.normal(k, shape, jnp.float32)

    x = jax.random.normal(ks[0], (BATCH, SEQ, D_MODEL), jnp.float32)
    offsets = jax.random.randint(ks[1], (BATCH, 1), 0, 1024, dtype=jnp.int32)
    positions = offsets + jnp.arange(SEQ, dtype=jnp.int32)[None, :]
    return {
        "x": x,
        "positions": positions,
        "w_in": w(ks[2], (DEPTH, D_MODEL, IN_DIM), D_MODEL),
        "q_norm": gain(ks[3], (DEPTH, Q_LORA_RANK)),
        "w_q_up": w(ks[4], (DEPTH, Q_LORA_RANK, N_HEADS * (QK_NOPE_DIM + QK_ROPE_DIM)), Q_LORA_RANK),
        "kv_norm": gain(ks[5], (DEPTH, KV_LORA_RANK)),
        "w_kv_up": w(ks[6], (DEPTH, KV_LORA_RANK, N_HEADS * (QK_NOPE_DIM + V_HEAD_DIM)), KV_LORA_RANK),
        "pool_w": w(ks[7], (DEPTH, POOL_GROUPS, POOL_GROUP_DIM, POOL_GROUP_DIM), POOL_GROUP_DIM),
        "pool_scale": gain(ks[8], (DEPTH, POOL_WIDTH)),
        "w_out": w(ks[9], (DEPTH, MIX_WIDTH, D_MODEL), MIX_WIDTH),
        "norm_pre_mix": gain(ks[10], (DEPTH, D_MODEL)),
        "norm_post_mix": gain(ks[11], (DEPTH, D_MODEL)),
        "norm_pre_ffn": gain(ks[12], (DEPTH, D_MODEL)),
        "norm_post_ffn": gain(ks[13], (DEPTH, D_MODEL)),
        "w_gate": w(ks[14], (DEPTH, D_MODEL, D_FF), D_MODEL),
        "w_up": w(ks[15], (DEPTH, D_MODEL, D_FF), D_MODEL),
        "w_down": w(ks[16], (DEPTH, D_FF, D_MODEL), D_FF),
    }


def reference(x, positions, w_in, q_norm, w_q_up, kv_norm, w_kv_up, pool_w, pool_scale, w_out,
              norm_pre_mix, norm_post_mix, norm_pre_ffn, norm_post_ffn, w_gate, w_up, w_down):
    cos, sin = rope_tables(positions, x.dtype)
    h = x
    for l in range(DEPTH):
        a = rmsnorm(h, norm_pre_mix[l])
        m = hybrid_mixer(a, cos, sin, w_in[l], q_norm[l], w_q_up[l], kv_norm[l], w_kv_up[l],
                         pool_w[l], pool_scale[l], w_out[l])
        h = h + rmsnorm(m, norm_post_mix[l])
        f = swiglu(rmsnorm(h, norm_pre_ffn[l]), w_gate[l], w_up[l], w_down[l])
        h = h + rmsnorm(f, norm_post_ffn[l])
    return h
```

```cpp
#include <hip/hip_runtime.h>
#include <cstdio>
#include <cstdint>

constexpr int BATCH = 2, SEQ = 8192, M = BATCH * SEQ, DM = 4096, NH = 16;
constexpr int DNOPE = 128, DROPE = 64, DQK = 192, DV = 128;
constexpr int QLR = 896, KVLR = 512, IN_DIM = 3520, IN_PAD = 3584, POOLW = 2048, PGD = 512, DFF = 11008;
constexpr int QW = NH * DQK, KVW = NH * (DNOPE + DV);
constexpr int OQ = 0, OKV = QLR, OROPE = QLR + KVLR, OU = QLR + KVLR + DROPE;
constexpr float EPS = 1e-6f;
constexpr float QSCALE = 0.07216878364870322f * 1.4426950408889634f;

constexpr size_t MiB = 1u << 20;
constexpr size_t WS_CTL = 0, CTL_ZERO_BYTES = 64 * 1024;
constexpr size_t WS_RS = 512 * 1024;
constexpr size_t WS_ROPE = 1 * MiB;
constexpr size_t WS_W0 = 8 * MiB, W_LAYER = 330 * MiB;
constexpr size_t WO_IN = 0, WO_Q = 28 * MiB, WO_KV = 34 * MiB, WO_POOL = 38 * MiB, WO_OUT = 40 * MiB, WO_GU = 72 * MiB, WO_DN = 244 * MiB;
constexpr size_t WS_A = 668 * MiB;
constexpr size_t WS_MB = 796 * MiB;
constexpr size_t WS_ACT = 924 * MiB;
constexpr size_t WS_Z = 924 * MiB;
constexpr size_t WS_CQN = 1036 * MiB;
constexpr size_t WS_CKVN = 1064 * MiB;
constexpr size_t WS_KROPE = 1080 * MiB;
constexpr size_t WS_DP = 1082 * MiB;
constexpr size_t WS_Q = 1146 * MiB;
constexpr size_t WS_KIMG = 1268 * MiB;
constexpr size_t WS_VIMG = 1332 * MiB;
constexpr size_t WS_CAT = 1396 * MiB;
constexpr size_t WS_END = 1524 * MiB;
static_assert(WS_Q + (size_t)M * QW * 2 <= WS_ACT + (size_t)M * DFF * 2 && WS_ACT + (size_t)M * DFF * 2 <= WS_KIMG, "ws map");

constexpr int CW_TMO = 0, CW_BAR = 4096;

constexpr int RING_BYTES = 131072, LDSCTL_OFF = RING_BYTES, MISC_OFF = LDSCTL_OFF + 320, LDS_BYTES = 147456;
constexpr int NWAVES = 8;

#define GAS __attribute__((address_space(1)))
#define LAS __attribute__((address_space(3)))
typedef unsigned short bf16_t;
typedef unsigned v4u __attribute__((ext_vector_type(4)));
typedef unsigned v2u __attribute__((ext_vector_type(2)));
typedef float f32x4 __attribute__((ext_vector_type(4)));
typedef float f32x16 __attribute__((ext_vector_type(16)));
typedef short bf16x8 __attribute__((ext_vector_type(8)));
typedef short s16x4 __attribute__((ext_vector_type(4)));
#define LDS_WAIT() asm volatile("s_waitcnt lgkmcnt(0)" ::: "memory")

__device__ __forceinline__ unsigned cvt_pk_bf16(float lo, float hi) { unsigned r; asm volatile("v_cvt_pk_bf16_f32 %0, %1, %2" : "=v"(r) : "v"(lo), "v"(hi)); return r; }
__device__ __forceinline__ unsigned f2bf(float f) { unsigned u = __builtin_bit_cast(unsigned, f); return (u + 0x7fffu + ((u >> 16) & 1u)) >> 16; }
__device__ __forceinline__ unsigned pk2(float lo, float hi) { return f2bf(lo) | (f2bf(hi) << 16); }
__device__ __forceinline__ float bflo(unsigned w) { return __uint_as_float(w << 16); }
__device__ __forceinline__ float bfhi(unsigned w) { return __uint_as_float(w & 0xffff0000u); }
__device__ __forceinline__ float bf2f(unsigned short b) { return __uint_as_float(((unsigned)b) << 16); }
__device__ __forceinline__ float wave_sum(float v) {
#pragma unroll
    for (int o = 1; o < 64; o <<= 1) v += __shfl_xor(v, o);
    return v;
}

namespace pg8 {
#define PG8_LAS __attribute__((address_space(3)))
typedef unsigned u32x4 __attribute__((ext_vector_type(4)));
constexpr int BM = 256, BK = 64, HALF = 128, HTB = HALF * BK * 2, STAGE_BYTES = 8 * HTB, NXCD = 8, WGM = 8;

__host__ __device__ __forceinline__ int lds_byte(int r, int c) { const int st = (r >> 4) * 2 + (c >> 5), rr = r & 15, cc = c & 31, ob = rr * 64 + cc * 2; return st * 1024 + (ob ^ (((ob >> 9) & 1) << 5)); }
__host__ __device__ __forceinline__ void stage_rc(int b, int& R, int& C) { const int st = b / 1024, sb = b % 1024, swz = sb ^ (((sb >> 9) & 1) << 5); R = (st >> 1) * 16 + swz / 64; C = (st & 1) * 32 + (swz % 64) / 2; }
__host__ __device__ __forceinline__ int perm32(int rho) { const int n = rho >> 4, i = rho & 15; return 8 * (i >> 2) + 4 * n + (i & 3); }

struct Unit { int pm, pn; };
struct Gemm { const bf16_t* A; const bf16_t* Bt; int M, N, K, lda, agrp; };

struct StaticOrder {
    int nM, nN, nwg, G, c, wgm, rev = 0;
    __host__ __device__ void init(int M_, int N_, int G_, int c_, int wgm_ = WGM) { nM = M_ / BM; nN = N_ / BM; nwg = nM * nN; G = G_; c = c_; wgm = wgm_; }
    __host__ __device__ bool next(int i, Unit& u) const {
        const long L = (long)i * G + c; if (L >= nwg) return false;
        int wgid = (int)L; { const int q = nwg / NXCD, r = nwg % NXCD, xcd = wgid % NXCD, off = wgid / NXCD; wgid = (xcd < r ? xcd * (q + 1) : r * (q + 1) + (xcd - r) * q) + off; }
        const int nig = wgm * nN, gid = wgid / nig, fm = gid * wgm, gsz = (nM - fm) < wgm ? (nM - fm) : wgm;
        u.pm = fm + ((wgid % nig) % gsz); u.pn = (wgid % nig) / gsz; if (rev) u.pn = nN - 1 - u.pn; return true;
    }
};

__device__ __forceinline__ u32x4 pack8(const f32x4 a, const f32x4 b) { u32x4 w; w.x = cvt_pk_bf16(a[0], a[1]); w.y = cvt_pk_bf16(a[2], a[3]); w.z = cvt_pk_bf16(b[0], b[1]); w.w = cvt_pk_bf16(b[2], b[3]); return w; }

struct EpiStore {
    static constexpr bool PERM = true;
    bf16_t* O; int ldc; float scale; const float* rs;
    __device__ __forceinline__ void operator()(const f32x4 (&acc)[2][2][4][2], const Unit& u, int wr, int wc, int fr, int fq) const {
        const int row0 = u.pm * BM + wr * 64 + fr, col0 = u.pn * BM + wc * 32 + 8 * fq;
#pragma unroll
        for (int ai = 0; ai < 2; ++ai)
#pragma unroll
            for (int m = 0; m < 4; ++m) { const int row = row0 + ai * HALF + m * 16; bf16_t* rowp = O + (size_t)row * ldc + col0;
                const float s = rs ? scale * rs[row] : scale;
#pragma unroll
                for (int bj = 0; bj < 2; ++bj) *(u32x4*)(rowp + bj * HALF) = pack8(acc[ai][bj][m][0] * s, acc[ai][bj][m][1] * s); }
    }
};
struct EpiPool {
    static constexpr bool PERM = true;
    bf16_t* O; const float* ps;
    __device__ __forceinline__ void operator()(const f32x4 (&acc)[2][2][4][2], const Unit& u, int wr, int wc, int fr, int fq) const {
        const int row0 = u.pm * BM + wr * 64 + fr, col0 = u.pn * BM + wc * 32 + 8 * fq;
        f32x4 sv[2][2];
#pragma unroll
        for (int bj = 0; bj < 2; ++bj)
#pragma unroll
            for (int n = 0; n < 2; ++n) sv[bj][n] = *(const f32x4*)(ps + col0 + bj * HALF + 4 * n);
#pragma unroll
        for (int ai = 0; ai < 2; ++ai)
#pragma unroll
            for (int m = 0; m < 4; ++m) { bf16_t* rowp = O + (size_t)(row0 + ai * HALF + m * 16) * DM + POOLW + col0;
#pragma unroll
                for (int bj = 0; bj < 2; ++bj) *(u32x4*)(rowp + bj * HALF) = pack8(acc[ai][bj][m][0] * sv[bj][0], acc[ai][bj][m][1] * sv[bj][1]); }
    }
};
struct EpiKV {
    static constexpr bool PERM = true;
    unsigned char* kimg; unsigned char* vimg;
    __device__ __forceinline__ void operator()(const f32x4 (&acc)[2][2][4][2], const Unit& u, int wr, int wc, int fr, int fq) const {
        const int b = u.pm >> 5, pmm = u.pm & 31, h = u.pn;
#pragma unroll
        for (int ai = 0; ai < 2; ++ai)
#pragma unroll
            for (int m = 0; m < 4; ++m) {
                const int T = pmm * 4 + 2 * ai + wr, k = 16 * m + fr;
                const size_t tile = (size_t)((b * NH + h) * 128 + T) * 16384;
                *(u32x4*)(kimg + tile + (4 * wc + fq) * 1024 + k * 16) = pack8(acc[ai][0][m][0], acc[ai][0][m][1]);
                const int kk = k;
                *(u32x4*)(vimg + tile + ((kk >> 3) * 4 + wc) * 512 + ((kk & 7) * 32 + 8 * fq) * 2) = pack8(acc[ai][1][m][0], acc[ai][1][m][1]);
            }
    }
};
struct EpiSwiGLU {
    static constexpr bool PERM = true;
    bf16_t* O; const float* rs;
    __device__ __forceinline__ static float silu_mul(float g, float u) { const float e = __builtin_amdgcn_exp2f(g * -1.4426950408889634f); return g * __builtin_amdgcn_rcpf(1.0f + e) * u; }
    __device__ __forceinline__ void operator()(const f32x4 (&acc)[2][2][4][2], const Unit& u, int wr, int wc, int fr, int fq) const {
        const int row0 = u.pm * BM + wr * 64 + fr, col0 = u.pn * HALF + wc * 32 + 8 * fq;
#pragma unroll
        for (int ai = 0; ai < 2; ++ai)
#pragma unroll
            for (int m = 0; m < 4; ++m) { const int row = row0 + ai * HALF + m * 16; bf16_t* rowp = O + (size_t)row * DFF + col0;
                const float s = rs[row];
                f32x4 v0, v1;
#pragma unroll
                for (int j = 0; j < 4; ++j) { v0[j] = silu_mul(acc[ai][0][m][0][j] * s, acc[ai][1][m][0][j] * s); v1[j] = silu_mul(acc[ai][0][m][1][j] * s, acc[ai][1][m][1][j] * s); }
                *(u32x4*)rowp = pack8(v0, v1); }
    }
};

template <class Epi, bool ALIGN_EPI = true, bool SP2 = true>
__device__ __forceinline__ void gemm_phase(PG8_LAS unsigned char* lds, const Gemm g, const StaticOrder& S, const Epi& E) {
    int tid = threadIdx.x; asm volatile("" : "+v"(tid));
    const int wid = __builtin_amdgcn_readfirstlane(tid >> 6), lane = tid & 63, wr = wid >> 2, wc = wid & 3, fr = lane & 15, fq = lane >> 4;
    const int K = g.K, nt = K / BK, lda = g.lda;
    unsigned voffA[2], voffB[2];
#pragma unroll
    for (int i = 0; i < 2; ++i) { int R, C; stage_rc(tid * 16 + i * 8192, R, C); const int Rb = Epi::PERM ? ((R & ~31) + perm32(R & 31)) : R;
        voffA[i] = (unsigned)(R * lda + C) * 2u; voffB[i] = (unsigned)(Rb * K + C) * 2u; }
    const size_t kstep = (size_t)(BK * 2);
    const size_t hstepA = (size_t)HALF * lda * 2, hstepB = (size_t)HALF * K * 2;
    const size_t tstepA = 2 * hstepA, tstepB = 2 * hstepB;
    const unsigned ldsw = (unsigned)wid * 1024u;
    const int aoff = lds_byte(wr * 64 + fr, fq * 8), boff = lds_byte(wc * 32 + fr, fq * 8);
#define PG8_SA(b, h) (((b) * 2 + (h)) * HTB)
#define PG8_SB(b, h) ((4 + (b) * 2 + (h)) * HTB)
#define PG8_STAGE(bufoff, gbase, voff) do { _Pragma("unroll") for (int _i = 0; _i < 2; ++_i) \
        __builtin_amdgcn_global_load_lds((const unsigned*)((const char*)(gbase) + (voff)[_i]), (PG8_LAS unsigned*)(lds + (bufoff) + ldsw + _i * 8192), 16, 0, 0); } while (0)
#define PG8_LDA(dst, b, h) do { _Pragma("unroll") for (int m = 0; m < 4; ++m) _Pragma("unroll") for (int k = 0; k < 2; ++k) dst[m][k] = *(const PG8_LAS bf16x8*)(lds + PG8_SA(b, h) + aoff + m * 2048 + k * 1024); } while (0)
#define PG8_LDB(dst, b, h) do { _Pragma("unroll") for (int n = 0; n < 2; ++n) _Pragma("unroll") for (int k = 0; k < 2; ++k) dst[n][k] = *(const PG8_LAS bf16x8*)(lds + PG8_SB(b, h) + boff + n * 2048 + k * 1024); } while (0)
#define PG8_MMA(ai, bj, At, Bt) do { __builtin_amdgcn_s_setprio(1); _Pragma("unroll") for (int m = 0; m < 4; ++m) _Pragma("unroll") for (int n = 0; n < 2; ++n) _Pragma("unroll") for (int k = 0; k < 2; ++k) \
        acc[ai][bj][m][n] = __builtin_amdgcn_mfma_f32_16x16x32_bf16(Bt[n][k], At[m][k], acc[ai][bj][m][n], 0, 0, 0); __builtin_amdgcn_s_setprio(0); } while (0)
#define PG8_WAIT_V(n) asm volatile("s_waitcnt vmcnt(" #n ")" ::: "memory")
#define PG8_WAIT_L(n) asm volatile("s_waitcnt lgkmcnt(" #n ")" ::: "memory")
#define PG8_BAR __builtin_amdgcn_s_barrier()
#define PG8_SCHED __builtin_amdgcn_sched_barrier(0)
    Unit cur, nxt; int ui = 0;
    if (!S.next(0, cur)) return;
    f32x4 acc[2][2][4][2];
#pragma unroll
    for (int a = 0; a < 2; ++a)
#pragma unroll
        for (int b = 0; b < 2; ++b)
#pragma unroll
            for (int m = 0; m < 4; ++m)
#pragma unroll
                for (int n = 0; n < 2; ++n) acc[a][b][m][n] = (f32x4){0.f, 0.f, 0.f, 0.f};
    bf16x8 At[4][2], B0[2][2], B1[2][2];
    const char* cA = (const char*)g.A + (size_t)cur.pm * tstepA + (size_t)((cur.pn >> 1) * g.agrp) * 2; const char* cB = (const char*)g.Bt + (size_t)cur.pn * tstepB;
    if constexpr (SP2) {
        PG8_STAGE(PG8_SB(0, 0), cB, voffB); PG8_STAGE(PG8_SB(0, 1), cB + hstepB, voffB); PG8_STAGE(PG8_SA(0, 0), cA, voffA); PG8_STAGE(PG8_SA(0, 1), cA + hstepA, voffA);
        if (wr == 1) PG8_BAR;
        PG8_WAIT_V(2); PG8_BAR;
        PG8_STAGE(PG8_SB(1, 0), cB + kstep, voffB); PG8_STAGE(PG8_SA(1, 0), cA + kstep, voffA); PG8_STAGE(PG8_SB(1, 1), cB + hstepB + kstep, voffB);
        PG8_WAIT_V(6); PG8_BAR;
    } else {
        PG8_STAGE(PG8_SB(0, 0), cB, voffB); PG8_STAGE(PG8_SA(0, 0), cA, voffA); PG8_STAGE(PG8_SB(0, 1), cB + hstepB, voffB); PG8_STAGE(PG8_SA(0, 1), cA + hstepA, voffA);
        if (wr == 1) PG8_BAR;
        PG8_WAIT_V(4); PG8_BAR;
        PG8_STAGE(PG8_SB(1, 0), cB + kstep, voffB); PG8_STAGE(PG8_SA(1, 0), cA + kstep, voffA); PG8_STAGE(PG8_SB(1, 1), cB + hstepB + kstep, voffB);
        PG8_WAIT_V(6); PG8_BAR;
    }
    for (;;) {
        const bool has_next = S.next(ui + 1, nxt);
        const char* nA = has_next ? (const char*)g.A + (size_t)nxt.pm * tstepA + (size_t)((nxt.pn >> 1) * g.agrp) * 2 : cA; const char* nB = has_next ? (const char*)g.Bt + (size_t)nxt.pn * tstepB : cB;
        for (int t = 0; t < nt; t += 2) {
            const bool last = (t == nt - 2);
            const char* a1 = cA + (size_t)(t + 1) * kstep;
            const char* a2 = last ? nA : cA + (size_t)(t + 2) * kstep; const char* b2 = last ? nB : cB + (size_t)(t + 2) * kstep;
            const char* a3 = a2 + kstep; const char* b3 = b2 + kstep;
            if constexpr (SP2) {
            PG8_LDB(B0, 0, 0); PG8_LDB(B1, 0, 1); PG8_SCHED; PG8_LDA(At, 0, 0); PG8_STAGE(PG8_SA(1, 1), a1 + hstepA, voffA);
            PG8_WAIT_V(8); PG8_WAIT_L(0); PG8_BAR; PG8_MMA(0, 0, At, B0); PG8_MMA(0, 1, At, B1); PG8_BAR; PG8_SCHED;
            PG8_LDA(At, 0, 1); PG8_STAGE(PG8_SB(0, 0), b2, voffB); PG8_STAGE(PG8_SB(0, 1), b2 + hstepB, voffB); PG8_STAGE(PG8_SA(0, 0), a2, voffA);
            PG8_WAIT_V(8); PG8_WAIT_L(0); PG8_BAR; PG8_MMA(1, 0, At, B0); PG8_MMA(1, 1, At, B1); PG8_BAR; PG8_SCHED;
            PG8_LDB(B0, 1, 0); PG8_LDB(B1, 1, 1); PG8_SCHED; PG8_LDA(At, 1, 0); PG8_STAGE(PG8_SA(0, 1), a2 + hstepA, voffA);
            PG8_WAIT_V(8); PG8_WAIT_L(0); PG8_BAR; PG8_MMA(0, 0, At, B0); PG8_MMA(0, 1, At, B1); PG8_BAR; PG8_SCHED;
            PG8_LDA(At, 1, 1); PG8_STAGE(PG8_SB(1, 0), b3, voffB); PG8_STAGE(PG8_SB(1, 1), b3 + hstepB, voffB); PG8_STAGE(PG8_SA(1, 0), a3, voffA);
            PG8_WAIT_V(8); PG8_WAIT_L(0); PG8_BAR; PG8_MMA(1, 0, At, B0); PG8_MMA(1, 1, At, B1); PG8_BAR; PG8_SCHED;
            } else {
            PG8_LDB(B0, 0, 0); PG8_SCHED; PG8_LDA(At, 0, 0); PG8_STAGE(PG8_SA(1, 1), a1 + hstepA, voffA);
            PG8_WAIT_L(8); PG8_BAR; PG8_WAIT_L(0); PG8_MMA(0, 0, At, B0); PG8_BAR; PG8_SCHED;
            PG8_LDB(B1, 0, 1); PG8_STAGE(PG8_SB(0, 0), b2, voffB);
            PG8_BAR; PG8_WAIT_L(0); PG8_MMA(0, 1, At, B1); PG8_BAR;
            PG8_LDA(At, 0, 1); PG8_STAGE(PG8_SA(0, 0), a2, voffA);
            PG8_BAR; PG8_WAIT_L(0); PG8_MMA(1, 0, At, B0); PG8_BAR; PG8_SCHED;
            PG8_STAGE(PG8_SB(0, 1), b2 + hstepB, voffB);
            PG8_WAIT_V(6); PG8_BAR; PG8_MMA(1, 1, At, B1); PG8_BAR;
            PG8_LDB(B0, 1, 0); PG8_SCHED; PG8_LDA(At, 1, 0); PG8_STAGE(PG8_SA(0, 1), a2 + hstepA, voffA);
            PG8_WAIT_L(8); PG8_BAR; PG8_WAIT_L(0); PG8_MMA(0, 0, At, B0); PG8_BAR; PG8_SCHED;
            PG8_LDB(B1, 1, 1); PG8_STAGE(PG8_SB(1, 0), b3, voffB);
            PG8_BAR; PG8_WAIT_L(0); PG8_MMA(0, 1, At, B1); PG8_BAR;
            PG8_LDA(At, 1, 1); PG8_STAGE(PG8_SA(1, 0), a3, voffA);
            PG8_BAR; PG8_WAIT_L(0); PG8_MMA(1, 0, At, B0); PG8_BAR; PG8_SCHED;
            PG8_STAGE(PG8_SB(1, 1), b3 + hstepB, voffB);
            PG8_WAIT_V(6); PG8_BAR; PG8_MMA(1, 1, At, B1); PG8_BAR;
            }
        }
        if constexpr (ALIGN_EPI) { if (wr == 0) PG8_BAR; }
        E(acc, cur, wr, wc, fr, fq);
        if (!has_next) break;
#pragma unroll
        for (int a = 0; a < 2; ++a)
#pragma unroll
            for (int b = 0; b < 2; ++b)
#pragma unroll
                for (int m = 0; m < 4; ++m)
#pragma unroll
                    for (int n = 0; n < 2; ++n) acc[a][b][m][n] = (f32x4){0.f, 0.f, 0.f, 0.f};
        cur = nxt; cA = nA; cB = nB; ++ui;
        if constexpr (ALIGN_EPI) { if (wr == 1) PG8_BAR; }
    }
    PG8_WAIT_V(0);
    if constexpr (!ALIGN_EPI) { if (wr == 0) PG8_BAR; }
    PG8_BAR;
#undef PG8_SA
#undef PG8_SB
#undef PG8_STAGE
#undef PG8_LDA
#undef PG8_LDB
#undef PG8_MMA
#undef PG8_WAIT_V
#undef PG8_WAIT_L
#undef PG8_BAR
#undef PG8_SCHED
}
}

namespace att {
typedef float f32x2_c __attribute__((ext_vector_type(2)));
typedef __bf16 bf16x2_c __attribute__((ext_vector_type(2)));
__device__ __forceinline__ unsigned cvt_pk(float lo, float hi) { f32x2_c v = {lo, hi}; bf16x2_c b = __builtin_convertvector(v, bf16x2_c); return __builtin_bit_cast(unsigned, b); }
constexpr int SLOTB = 40960, NSLOT = 3, ROFF = 16384, VOFF = 24576, LDS_WS = NSLOT * SLOTB, ATT_LDS_BYTES = LDS_WS + NWAVES * 256;
static_assert(ATT_LDS_BYTES <= RING_BYTES, "attention LDS");
#define SBAR() __builtin_amdgcn_sched_barrier(0)
__device__ __forceinline__ void glds16(const void* gsrc, unsigned lds_dst) { unsigned keep;
    asm volatile("s_mov_b32 %0, m0\n\ts_mov_b32 m0, %2\n\ts_nop 0\n\tglobal_load_lds_dwordx4 %1, off\n\ts_mov_b32 m0, %0" : "=&s"(keep) : "v"(gsrc), "s"(lds_dst) : "memory"); }
#define ATT_WAIT_BAR(N) asm volatile("s_waitcnt vmcnt(" #N ") lgkmcnt(0)\n\ts_barrier" ::: "memory")
typedef __attribute__((address_space(3))) const unsigned char* lds_cptr;
typedef __attribute__((address_space(3))) const bf16x8* lds_b128p;
typedef float f32x4_t __attribute__((ext_vector_type(4)));
#define MFMA16(X, Y, C) __builtin_amdgcn_mfma_f32_16x16x32_bf16(X, Y, C, 0, 0, 0)
constexpr float PLIM = 16384.f;
__device__ __forceinline__ float fadd_s(float a, float b) { float r; asm("v_add_f32_e32 %0, %1, %2" : "=v"(r) : "v"(a), "v"(b)); return r; }

__device__ __forceinline__ void cmask(f32x4 (&s)[4][2], int jb, int qrel0, int g) {
    const float NEG = -__builtin_inff();
#pragma unroll
    for (int kb = 0; kb < 4; ++kb)
#pragma unroll
        for (int r = 0; r < 4; ++r) { const int kv = 64 * jb + 16 * kb + 4 * g + r; if (kv > qrel0) s[kb][0][r] = NEG; if (kv > qrel0 + 16) s[kb][1][r] = NEG; }
}
#define ATT_KLD(dst, ks) do { _Pragma("unroll") for (int kb = 0; kb < 4; ++kb) dst[kb] = *(lds_b128p)(kb_ + (ks) * 4096 + kb * 256); } while (0)
#define ATT_KMM(src, ks) do { _Pragma("unroll") for (int kb = 0; kb < 4; ++kb) { s[kb][0] = MFMA16(src[kb], qr[0][ks], s[kb][0]); s[kb][1] = MFMA16(src[kb], qr[1][ks], s[kb][1]); } } while (0)
__device__ __forceinline__ void qkt(f32x4 (&s)[4][2], lds_cptr kb_, const bf16x8 (&qr)[2][6], const f32x4 (&negm)[2]) {
    bf16x8 ka[4], kc[4];
    ATT_KLD(ka, 0); ATT_KLD(kc, 1); SBAR();
#pragma unroll
    for (int kb = 0; kb < 4; ++kb) { s[kb][0] = MFMA16(ka[kb], qr[0][0], negm[0]); s[kb][1] = MFMA16(ka[kb], qr[1][0], negm[1]); }
    SBAR(); ATT_KLD(ka, 2); SBAR();
    ATT_KMM(kc, 1); SBAR(); ATT_KLD(kc, 3); SBAR();
    ATT_KMM(ka, 2); SBAR(); ATT_KLD(ka, 4); SBAR();
    ATT_KMM(kc, 3); SBAR(); ATT_KLD(kc, 5); SBAR();
    ATT_KMM(ka, 4); SBAR();
    ATT_KMM(kc, 5);
}
#undef ATT_KLD
#undef ATT_KMM
#define ATT_PACK() do { _Pragma("unroll") for (int qb = 0; qb < 2; ++qb) _Pragma("unroll") for (int h2 = 0; h2 < 2; ++h2) { \
        v4u w = {cvt_pk(s[2 * h2][qb][0], s[2 * h2][qb][1]), cvt_pk(s[2 * h2][qb][2], s[2 * h2][qb][3]), cvt_pk(s[2 * h2 + 1][qb][0], s[2 * h2 + 1][qb][1]), cvt_pk(s[2 * h2 + 1][qb][2], s[2 * h2 + 1][qb][3])}; \
        pa[qb][h2] = __builtin_bit_cast(bf16x8, w); } } while (0)
__device__ __forceinline__ bool softmax_fast(f32x4 (&s)[4][2], float (&l_reg)[2], bf16x8 (&pa)[2][2]) {
#pragma unroll
    for (int kb = 0; kb < 4; ++kb)
#pragma unroll
        for (int qb = 0; qb < 2; ++qb)
#pragma unroll
            for (int r = 0; r < 4; ++r) s[kb][qb][r] = __builtin_amdgcn_exp2f(s[kb][qb][r]);
    float ps0 = s[0][0][0];
#pragma unroll
    for (int kb = 0; kb < 4; ++kb)
#pragma unroll
        for (int r = 0; r < 4; ++r) if (kb + r > 0) ps0 += s[kb][0][r];
    float ps1 = s[0][1][0]; asm volatile("" : "+v"(ps0), "+v"(ps1));
#pragma unroll
    for (int kb = 0; kb < 4; ++kb)
#pragma unroll
        for (int r = 0; r < 4; ++r) if (kb + r > 0) ps1 += s[kb][1][r];
    if (__builtin_expect(!__all(ps0 <= PLIM && ps1 <= PLIM), 0)) return false;
    l_reg[0] += ps0; l_reg[1] += ps1;
    ATT_PACK();
    return true;
}
__device__ __forceinline__ void softmax_exact(f32x4 (&s)[4][2], float (&mref)[2], f32x4 (&negm)[2], bool first, float (&l_reg)[2], float (&alpha)[2], bf16x8 (&pa)[2][2]) {
#pragma unroll
    for (int qb = 0; qb < 2; ++qb) {
        float pmax = s[0][qb][0];
#pragma unroll
        for (int kb = 0; kb < 4; ++kb)
#pragma unroll
            for (int r = 0; r < 4; ++r) pmax = fmaxf(pmax, s[kb][qb][r]);
        pmax = fmaxf(pmax, __shfl_xor(pmax, 16)); pmax = fmaxf(pmax, __shfl_xor(pmax, 32));
        const float d = first ? pmax : fmaxf(pmax, 0.f); alpha[qb] = first ? 1.f : __builtin_amdgcn_exp2f(-d); mref[qb] += d;
        const float nm = -mref[qb]; negm[qb] = (f32x4){nm, nm, nm, nm};
        float ps = 0.f;
#pragma unroll
        for (int kb = 0; kb < 4; ++kb)
#pragma unroll
            for (int r = 0; r < 4; ++r) { s[kb][qb][r] = __builtin_amdgcn_exp2f(s[kb][qb][r] - d); ps += s[kb][qb][r]; }
        l_reg[qb] = l_reg[qb] * alpha[qb] + ps;
    }
    asm volatile("" : "+v"(negm[0]), "+v"(negm[1]));
    ATT_PACK();
}
#undef ATT_PACK
typedef short v4i16_t __attribute__((ext_vector_type(4)));
__device__ __forceinline__ s16x4 vtr(lds_cptr p) { return __builtin_bit_cast(s16x4, __builtin_amdgcn_ds_read_tr16_b64_v4i16((__attribute__((address_space(3))) v4i16_t*)p)); }
#define ATT_VLD(L, H, n) do { _Pragma("unroll") for (int c = 0; c < 4; ++c) { const int cb = 4 * ((n) & 1) + c; L[c] = vtr(vp + ((n) >> 1) * 8192 + (cb >> 1) * 512 + (cb & 1) * 32); H[c] = vtr(vp + ((n) >> 1) * 8192 + 4096 + (cb >> 1) * 512 + (cb & 1) * 32); } } while (0)
#define ATT_VFR(L, H, c) (bf16x8){L[c][0], L[c][1], L[c][2], L[c][3], H[c][0], H[c][1], H[c][2], H[c][3]}
#define ATT_VMM(L, H, n) do { _Pragma("unroll") for (int c = 0; c < 4; ++c) { const int cb = 4 * ((n) & 1) + c; o[cb][0] = MFMA16(ATT_VFR(L, H, c), pa[0][(n) >> 1], o[cb][0]); o[cb][1] = MFMA16(ATT_VFR(L, H, c), pa[1][(n) >> 1], o[cb][1]); } } while (0)
__device__ __forceinline__ void pv_tile(f32x4 (&o)[8][2], lds_cptr vp, const bf16x8 (&pa)[2][2]) {
    s16x4 la[4], ha[4], lb[4], hb[4];
    ATT_VLD(la, ha, 0); ATT_VLD(lb, hb, 1); SBAR();
    ATT_VMM(la, ha, 0); SBAR(); ATT_VLD(la, ha, 2); SBAR();
    ATT_VMM(lb, hb, 1); SBAR(); ATT_VLD(lb, hb, 3); SBAR();
    ATT_VMM(la, ha, 2); SBAR();
    ATT_VMM(lb, hb, 3);
}
#undef ATT_VLD
#undef ATT_VFR
#undef ATT_VMM

__device__ __forceinline__ void attn_unit(int b, int h, int qb_, const bf16_t* Q, const unsigned char* kimg, const unsigned char* vimg, const unsigned char* rimg,
                                          const float* tab, bf16_t* O, LAS unsigned char* lds) {
    int tid = threadIdx.x; asm volatile("" : "+v"(tid));
    const int lane = tid & 63, l15 = lane & 15, g = lane >> 4; const int wid = __builtin_amdgcn_readfirstlane(tid >> 6);
    const int q0 = qb_ * 256; const long rowbase = (long)b * SEQ;
    const int NT = 4 * (qb_ + 1);
    const unsigned lds0 = (unsigned)(uintptr_t)lds;
    const unsigned char* kp = kimg + (size_t)((b * NH + h) * 128) * 16384 + (size_t)(2 * wid) * 1024 + lane * 16;
    const unsigned char* vp = vimg + (size_t)((b * NH + h) * 128) * 16384 + (size_t)(2 * wid) * 1024 + lane * 16;
    const unsigned char* rp = rimg + (size_t)(b * 128) * 8192 + (size_t)wid * 1024 + lane * 16;
#define DMA_TILE(T, slotoff) do { const unsigned d_ = (unsigned)__builtin_amdgcn_readfirstlane((int)(lds0 + (unsigned)(slotoff) + (unsigned)(2 * wid) * 1024u)); \
        const unsigned dr_ = (unsigned)__builtin_amdgcn_readfirstlane((int)(lds0 + (unsigned)(slotoff) + (unsigned)ROFF + (unsigned)wid * 1024u)); \
        const unsigned char* k_ = kp + (size_t)(T) * 16384; const unsigned char* v_ = vp + (size_t)(T) * 16384; \
        glds16(k_, d_); glds16(k_ + 1024, d_ + 1024u); glds16(rp + (size_t)(T) * 8192, dr_); glds16(v_, d_ + (unsigned)VOFF); glds16(v_ + 1024, d_ + (unsigned)VOFF + 1024u); } while (0)
    DMA_TILE(0, 0);
    bf16x8 qr[2][6];
#pragma unroll
    for (int qb = 0; qb < 2; ++qb) {
        const long qrow = rowbase + q0 + wid * 32 + 16 * qb + l15;
        const bf16_t* Qw = Q + qrow * QW + h * DQK;
#pragma unroll
        for (int ks = 0; ks < 6; ++ks) qr[qb][ks] = *(const bf16x8*)(Qw + ks * 32 + g * 8);
        const float* tr = tab + qrow * 64 + 8 * g;
        const f32x4 c0 = *(const f32x4*)(tr), c1 = *(const f32x4*)(tr + 4), s0 = *(const f32x4*)(tr + 32), s1 = *(const f32x4*)(tr + 36);
        const bf16x8 x1 = qr[qb][4], x2 = qr[qb][5];
        float o1[8], o2[8];
#pragma unroll
        for (int e = 0; e < 8; ++e) { const float a = bf2f((unsigned short)x1[e]), bb = bf2f((unsigned short)x2[e]); const float c = e < 4 ? c0[e & 3] : c1[e & 3], s = e < 4 ? s0[e & 3] : s1[e & 3];
            o1[e] = a * c - bb * s; o2[e] = bb * c + a * s; }
        v4u w1 = {cvt_pk(o1[0], o1[1]), cvt_pk(o1[2], o1[3]), cvt_pk(o1[4], o1[5]), cvt_pk(o1[6], o1[7])};
        v4u w2 = {cvt_pk(o2[0], o2[1]), cvt_pk(o2[2], o2[3]), cvt_pk(o2[4], o2[5]), cvt_pk(o2[6], o2[7])};
        qr[qb][4] = __builtin_bit_cast(bf16x8, w1); qr[qb][5] = __builtin_bit_cast(bf16x8, w2);
    }
#pragma unroll
    for (int qb = 0; qb < 2; ++qb)
#pragma unroll
        for (int ks = 0; ks < 6; ++ks) asm volatile("" : "+v"(qr[qb][ks]));
    float mref[2] = {0.f, 0.f}, l_reg[2] = {0.f, 0.f}; f32x4 o[8][2];
#pragma unroll
    for (int cb = 0; cb < 8; ++cb) { o[cb][0] = (f32x4){0.f, 0.f, 0.f, 0.f}; o[cb][1] = (f32x4){0.f, 0.f, 0.f, 0.f}; }
    f32x4 negm[2] = {(f32x4){0.f, 0.f, 0.f, 0.f}, (f32x4){0.f, 0.f, 0.f, 0.f}}; asm volatile("" : "+v"(negm[0]), "+v"(negm[1]));
    const int qrel0 = wid * 32 + l15;
    const lds_cptr kb0 = (lds_cptr)lds + g * 1024 + l15 * 16;
    const lds_cptr vb00 = (lds_cptr)lds + VOFF + (g >> 1) * 2048 + (g & 1) * 256 + (l15 >> 2) * 64 + (lane & 3) * 8;
    const bool young = wid >= 4;
    int sl = 0, sn = SLOTB;
    if (young) __builtin_amdgcn_s_setprio(1);
    ATT_WAIT_BAR(0);
    if (NT > 1) { DMA_TILE(1, sn); } sn = 2 * SLOTB;
#define ATT_STEP_BAR(t) do { ATT_WAIT_BAR(0); if ((t) + 2 < NT) { DMA_TILE((t) + 2, sn); } sn = (sn == (NSLOT - 1) * SLOTB) ? 0 : sn + SLOTB; } while (0)
#pragma unroll 1
    for (int t = 0; t < NT; ++t) {
        const bool live = !(t >= NT - 4 && 64 * (t - (NT - 4)) > 32 * wid + 31);
        if (live) {
            f32x4 s[4][2]; float alpha[2]; bf16x8 pa[2][2];
            qkt(s, kb0 + sl, qr, negm);
            const bool msk = t >= NT - 4 && 64 * (t - (NT - 4)) + 63 > 32 * wid;
            if (msk) cmask(s, t - (NT - 4), qrel0, g);
            bool redo = (t == 0);
            if (!redo) { redo = !softmax_fast(s, l_reg, pa);
                if (__builtin_expect(redo, 0)) { qkt(s, kb0 + sl, qr, negm); if (msk) cmask(s, t - (NT - 4), qrel0, g); } }
            if (__builtin_expect(redo, 0)) {
                softmax_exact(s, mref, negm, t == 0, l_reg, alpha, pa);
                if (__any(alpha[0] < 1.f || alpha[1] < 1.f)) {
#pragma unroll
                    for (int cb = 0; cb < 8; ++cb)
#pragma unroll
                        for (int r = 0; r < 4; ++r) { o[cb][0][r] *= alpha[0]; o[cb][1][r] *= alpha[1]; } } }
            SBAR();
            pv_tile(o, vb00 + sl, pa);
        }
        ATT_STEP_BAR(t);
        sl = (sl == (NSLOT - 1) * SLOTB) ? 0 : sl + SLOTB;
    }
#undef ATT_STEP_BAR
    if (young) __builtin_amdgcn_s_setprio(0);
#pragma unroll
    for (int qb = 0; qb < 2; ++qb) {
        float l = l_reg[qb]; l += __shfl_xor(l, 16); l += __shfl_xor(l, 32);
        const float rl = __builtin_amdgcn_rcpf(l);
        bf16_t* Ow = O + (size_t)(rowbase + q0 + wid * 32 + 16 * qb + l15) * DM + h * DV + 4 * g;
#pragma unroll
        for (int cb = 0; cb < 8; ++cb) { v2u w = {cvt_pk(o[cb][qb][0] * rl, o[cb][qb][1] * rl), cvt_pk(o[cb][qb][2] * rl, o[cb][qb][3] * rl)}; *(v2u*)(Ow + 16 * cb) = w; }
    }
#undef DMA_TILE
}
#undef SBAR
#undef ATT_WAIT_BAR
#undef MFMA16
}

#define XB_TMO      128
#define XB_XCNT(j)  (256  + 64 * (j))
#define XB_XSUB(j)  (1280 + 64 * (j))
#define XB_XGEN(j)  (2304 + 64 * (j))
#define XB_TOP      3328
#define XB_TOPGEN   3392
#define XCD_BAR_WORDS 3456
#define XB_SPIN_CAP (1u << 18)
__device__ __forceinline__ unsigned xb_ld(unsigned* p)              { return __hip_atomic_load(p, __ATOMIC_RELAXED, __HIP_MEMORY_SCOPE_AGENT); }
__device__ __forceinline__ unsigned xb_add(unsigned* p, unsigned v) { return __hip_atomic_fetch_add(p, v, __ATOMIC_RELAXED, __HIP_MEMORY_SCOPE_AGENT); }
__device__ __forceinline__ unsigned xb_xcc_id() { return (unsigned)__builtin_amdgcn_s_getreg((3 << 11) | 20) & 0xFu; }
#define XB_SPIN(cond, bar) do { unsigned _sp = 0; while (cond) { __builtin_amdgcn_s_sleep(1); \
    if ((++_sp & 255u) == 0u) { if (xb_ld(&(bar)[XB_TMO])) break; if (_sp > XB_SPIN_CAP) { atomicAdd(&(bar)[XB_TMO], 1u); break; } } } } while (0)
struct XcdBarrier { unsigned* bar; unsigned x; volatile LAS unsigned* st; };
__device__ __forceinline__ XcdBarrier xcd_barrier_post(unsigned* bar, volatile LAS unsigned* st) {
    XcdBarrier b; b.bar = bar; b.x = (unsigned)__builtin_amdgcn_readfirstlane((int)xb_xcc_id()); b.st = st;
    if (threadIdx.x == 0) (void)xb_add(&bar[XB_XCNT(b.x)], 1u);
    return b;
}
__device__ __forceinline__ void xcd_barrier_complete(unsigned* bar, unsigned x, unsigned& nloc, unsigned& nx) {
    const unsigned G = gridDim.x * gridDim.y * gridDim.z;
    unsigned sum, cnt, mine, sp = 0u;
    for (;;) {
        sum = 0u; cnt = 0u; mine = 0u;
#pragma unroll
        for (unsigned j = 0; j < 16; ++j) { const unsigned c = xb_ld(&bar[XB_XCNT(j)]); sum += c; cnt += (c > 0u) ? 1u : 0u; mine = (j == x) ? c : mine; }
        if (sum == G) break;
        __builtin_amdgcn_s_sleep(1);
        if ((++sp & 255u) == 0u) { if (xb_ld(&bar[XB_TMO])) break; if (sp > XB_SPIN_CAP) { atomicAdd(&bar[XB_TMO], 1u); break; } }
    }
    nloc = mine > 0u ? mine : 1u; nx = cnt > 0u ? cnt : 1u;
}
__device__ __forceinline__ void xcd_barrier(const XcdBarrier& b) {
    asm volatile("s_waitcnt vmcnt(0)" ::: "memory");
    __syncthreads();
    if (threadIdx.x == 0) {
        unsigned* bar = b.bar;
        __builtin_amdgcn_s_waitcnt(0);
        unsigned nloc = b.st[0], nx = b.st[1];
        if (nloc == 0u) { xcd_barrier_complete(bar, b.x, nloc, nx); b.st[0] = nloc; b.st[1] = nx; }
        const unsigned old = xb_add(&bar[XB_XSUB(b.x)], 1u);
        const unsigned gen = old / nloc;
        if (old + 1u == (gen + 1u) * nloc) {
            __builtin_amdgcn_fence(__ATOMIC_RELEASE, "agent");
            asm volatile("s_waitcnt vmcnt(0)" ::: "memory");
            const unsigned og = xb_add(&bar[XB_TOP], 1u);
            const unsigned tg = og / nx;
            if (og + 1u == (tg + 1u) * nx) xb_add(&bar[XB_TOPGEN], 1u);
            else XB_SPIN(xb_ld(&bar[XB_TOPGEN]) == tg, bar);
            __builtin_amdgcn_fence(__ATOMIC_ACQUIRE, "agent");
            xb_add(&bar[XB_XGEN(b.x)], 1u);
            asm volatile("s_waitcnt vmcnt(0)" ::: "memory");
        } else {
            XB_SPIN(xb_ld(&bar[XB_XGEN(b.x)]) == gen, bar);
            __builtin_amdgcn_fence(__ATOMIC_ACQUIRE, "agent");
            asm volatile("s_waitcnt vmcnt(0)" ::: "memory");
        }
    }
    __syncthreads();
}

__device__ __forceinline__ void group_barrier32(unsigned* cnt) {
    asm volatile("s_waitcnt vmcnt(0)" ::: "memory");
    __syncthreads();
    if (threadIdx.x == 0) {
        __builtin_amdgcn_fence(__ATOMIC_RELEASE, "agent");
        asm volatile("s_waitcnt vmcnt(0)" ::: "memory");
        const unsigned old = xb_add(cnt, 1u);
        const unsigned target = ((old >> 5) + 1u) << 5;
        unsigned sp = 0u; while (xb_ld(cnt) < target) { __builtin_amdgcn_s_sleep(1); if (++sp > (1u << 22)) break; }
        __builtin_amdgcn_fence(__ATOMIC_ACQUIRE, "agent");
        asm volatile("s_waitcnt vmcnt(0)" ::: "memory");
    }
    __syncthreads();
}

struct Ctx { int tid, lane, wave, gw, NGW, gtid, NT; LAS unsigned char* lds; };
__device__ __forceinline__ Ctx make_ctx(LAS unsigned char* lds) {
    Ctx C; int tid = threadIdx.x; asm volatile("" : "+v"(tid));
    C.tid = tid; C.lane = tid & 63; C.wave = __builtin_amdgcn_readfirstlane(tid >> 6);
    const int G = gridDim.x, bx = blockIdx.x; const int vcu = (G % 8 == 0) ? (bx % 8) * (G / 8) + bx / 8 : bx;
    C.gw = vcu * NWAVES + C.wave; C.NGW = G * NWAVES; C.gtid = vcu * (NWAVES * 64) + tid; C.NT = G * NWAVES * 64; C.lds = lds; return C;
}

__device__ __forceinline__ void transpose_item(const float* W, int ldw, int k0, int n0, bf16_t* WT, int ldk, int row_dst, LAS float* scr, int lane, const float* gain = nullptr) {
#pragma unroll 8
    for (int i = 0; i < 32; ++i) { const int kk = 2 * i + (lane >> 5); scr[kk * 33 + (lane & 31)] = W[(size_t)(k0 + kk) * ldw + n0 + (lane & 31)]; }
    const int c = lane & 7;
    f32x4 g0 = {1.f, 1.f, 1.f, 1.f}, g1 = g0;
    if (gain) { g0 = *(const GAS f32x4*)(gain + k0 + 8 * c); g1 = *(const GAS f32x4*)(gain + k0 + 8 * c + 4); }
    LDS_WAIT(); asm volatile("" ::: "memory");
#pragma unroll
    for (int j = 0; j < 4; ++j) { const int n = (lane >> 3) + 8 * j; const LAS float* s = scr + (8 * c) * 33 + n;
        v4u o; o.x = pk2(s[0 * 33] * g0.x, s[1 * 33] * g0.y); o.y = pk2(s[2 * 33] * g0.z, s[3 * 33] * g0.w); o.z = pk2(s[4 * 33] * g1.x, s[5 * 33] * g1.y); o.w = pk2(s[6 * 33] * g1.z, s[7 * 33] * g1.w);
        *(GAS v4u*)(WT + (size_t)(row_dst + n) * ldk + k0 + 8 * c) = o; }
    LDS_WAIT(); asm volatile("" ::: "memory");
}
struct WSrc { const float *w_in, *w_q, *w_kv, *pool_w, *w_out, *w_gate, *w_up, *w_down, *g_mix, *g_ffn; };
__device__ __forceinline__ void convert_weights(LAS unsigned char* lds_, const WSrc& S, unsigned char* wl) {
    const Ctx C = make_ctx(lds_);
    LAS float* scr = (LAS float*)(C.lds + C.wave * 16384);
    constexpr int I_IN = (DM / 64) * (IN_DIM / 32), I_Q = (QLR / 64) * (QW / 32), I_KV = (KVLR / 64) * (KVW / 32), I_P = 4 * (PGD / 64) * (PGD / 32), I_O = (DM / 64) * (DM / 32),
                  I_G = (DM / 64) * (DFF / 32), I_D = (DFF / 64) * (DM / 32);
    constexpr int NITEMS = I_IN + I_Q + I_KV + I_P + I_O + 2 * I_G + I_D;
    bf16_t* t_in = (bf16_t*)(wl + WO_IN); bf16_t* t_q = (bf16_t*)(wl + WO_Q); bf16_t* t_kv = (bf16_t*)(wl + WO_KV); bf16_t* t_p = (bf16_t*)(wl + WO_POOL);
    bf16_t* t_o = (bf16_t*)(wl + WO_OUT); bf16_t* t_gu = (bf16_t*)(wl + WO_GU); bf16_t* t_dn = (bf16_t*)(wl + WO_DN);
    for (int it = C.gw; it < NITEMS; it += C.NGW) {
        int r = it;
        if (r < I_IN) { const int nb = IN_DIM / 32, kb = r / nb, n0 = (r % nb) * 32; transpose_item(S.w_in, IN_DIM, kb * 64, n0, t_in, DM, n0, scr, C.lane, S.g_mix); continue; } r -= I_IN;
        if (r < I_Q) { const int nb = QW / 32, kb = r / nb, n0 = (r % nb) * 32; transpose_item(S.w_q, QW, kb * 64, n0, t_q, QLR, n0, scr, C.lane); continue; } r -= I_Q;
        if (r < I_KV) { const int nb = KVW / 32, kb = r / nb, n0 = (r % nb) * 32; transpose_item(S.w_kv, KVW, kb * 64, n0, t_kv, KVLR, n0, scr, C.lane); continue; } r -= I_KV;
        if (r < I_P) { const int per = (PGD / 64) * (PGD / 32), gi = r / per, rr = r % per, nb = PGD / 32, kb = rr / nb, n0 = (rr % nb) * 32;
            transpose_item(S.pool_w + (size_t)gi * PGD * PGD, PGD, kb * 64, n0, t_p, PGD, gi * PGD + n0, scr, C.lane); continue; } r -= I_P;
        if (r < I_O) { const int nb = DM / 32, kb = r / nb, n0 = (r % nb) * 32; transpose_item(S.w_out, DM, kb * 64, n0, t_o, DM, n0, scr, C.lane); continue; } r -= I_O;
        if (r < I_G) { const int nb = DFF / 32, kb = r / nb, n0 = (r % nb) * 32; transpose_item(S.w_gate, DFF, kb * 64, n0, t_gu, DM, 256 * (n0 >> 7) + (n0 & 127), scr, C.lane, S.g_ffn); continue; } r -= I_G;
        if (r < I_G) { const int nb = DFF / 32, kb = r / nb, n0 = (r % nb) * 32; transpose_item(S.w_up, DFF, kb * 64, n0, t_gu, DM, 256 * (n0 >> 7) + 128 + (n0 & 127), scr, C.lane, S.g_ffn); continue; } r -= I_G;
        { const int nb = DM / 32, kb = r / nb, n0 = (r % nb) * 32; transpose_item(S.w_down, DM, kb * 64, n0, t_dn, DFF, n0, scr, C.lane); }
    }
    { v4u* p = (v4u*)(t_in + (size_t)IN_DIM * DM); const int n16 = (IN_PAD - IN_DIM) * DM * 2 / 16; for (int i = C.gtid; i < n16; i += C.NT) p[i] = (v4u){0u, 0u, 0u, 0u}; }
}
__device__ __forceinline__ void rope_table(LAS unsigned char* lds_, const int* pos, float* tab) {
    const Ctx C = make_ctx(lds_);
    for (int it = C.gtid; it < M * 32; it += C.NT) { const int m = it >> 5, i = it & 31;
        const float inv = powf(10000.0f, -(float)(2 * i) / 64.0f); const float ang = (float)pos[m] * inv;
        float s, c; sincosf(ang, &s, &c); tab[(size_t)m * 64 + i] = c; tab[(size_t)m * 64 + 32 + i] = s; }
}
__device__ __forceinline__ void xcopy_first(LAS unsigned char* lds_, const float* x, bf16_t* hb, float* rs) {
    const Ctx C = make_ctx(lds_);
    for (int m = C.gw; m < M; m += C.NGW) {
        const GAS f32x4* xr = (const GAS f32x4*)(x + (size_t)m * DM) + C.lane;
        f32x4 v[16]; float ss = 0.f;
#pragma unroll
        for (int j = 0; j < 16; ++j) { v[j] = xr[64 * j]; ss += (v[j].x * v[j].x + v[j].y * v[j].y) + (v[j].z * v[j].z + v[j].w * v[j].w); }
        ss = wave_sum(ss);
        if (C.lane == 0) rs[m] = rsqrtf(ss * (1.f / DM) + EPS);
        GAS v2u* o8 = (GAS v2u*)(hb + (size_t)m * DM) + C.lane;
#pragma unroll
        for (int j = 0; j < 16; ++j) { v2u w; w.x = pk2(v[j].x, v[j].y); w.y = pk2(v[j].z, v[j].w); o8[64 * j] = w; }
    }
}
template <bool HIN_F32, bool OUT_F32>
__device__ __forceinline__ void resnorm(LAS unsigned char* lds_, const bf16_t* mb, const void* hin_, const float* gpost, bf16_t* hb_out, float* outf, float* rs) {
    const Ctx C = make_ctx(lds_);
    for (int m = C.gw; m < M; m += C.NGW) {
        const GAS v4u* mr = (const GAS v4u*)(mb + (size_t)m * DM) + C.lane;
        v4u mw[8]; float ss = 0.f;
#pragma unroll
        for (int j = 0; j < 8; ++j) { mw[j] = mr[64 * j];
#pragma unroll
            for (int e = 0; e < 4; ++e) { const float lo = bflo(mw[j][e]), hi = bfhi(mw[j][e]); ss += lo * lo + hi * hi; } }
        const float rstd = rsqrtf(wave_sum(ss) * (1.f / DM) + EPS);
        float s2 = 0.f;
#pragma unroll
        for (int j = 0; j < 8; ++j) {
            const size_t col = (size_t)8 * (C.lane + 64 * j);
            f32x4 h0, h1;
            if constexpr (HIN_F32) { const float* hin = (const float*)hin_; h0 = *(const GAS f32x4*)(hin + (size_t)m * DM + col); h1 = *(const GAS f32x4*)(hin + (size_t)m * DM + col + 4); }
            else { const v4u hw = *(const GAS v4u*)((const bf16_t*)hin_ + (size_t)m * DM + col);
                   h0 = (f32x4){bflo(hw[0]), bfhi(hw[0]), bflo(hw[1]), bfhi(hw[1])}; h1 = (f32x4){bflo(hw[2]), bfhi(hw[2]), bflo(hw[3]), bfhi(hw[3])}; }
            const f32x4 g0 = *(const GAS f32x4*)(gpost + col), g1 = *(const GAS f32x4*)(gpost + col + 4);
            f32x4 a0, a1;
            a0.x = h0.x + bflo(mw[j][0]) * rstd * g0.x; a0.y = h0.y + bfhi(mw[j][0]) * rstd * g0.y; a0.z = h0.z + bflo(mw[j][1]) * rstd * g0.z; a0.w = h0.w + bfhi(mw[j][1]) * rstd * g0.w;
            a1.x = h1.x + bflo(mw[j][2]) * rstd * g1.x; a1.y = h1.y + bfhi(mw[j][2]) * rstd * g1.y; a1.z = h1.z + bflo(mw[j][3]) * rstd * g1.z; a1.w = h1.w + bfhi(mw[j][3]) * rstd * g1.w;
            if constexpr (OUT_F32) { *(GAS f32x4*)(outf + (size_t)m * DM + col) = a0; *(GAS f32x4*)(outf + (size_t)m * DM + col + 4) = a1; }
            else { s2 += (a0.x * a0.x + a0.y * a0.y) + (a0.z * a0.z + a0.w * a0.w) + (a1.x * a1.x + a1.y * a1.y) + (a1.z * a1.z + a1.w * a1.w);
                   v4u w; w.x = pk2(a0.x, a0.y); w.y = pk2(a0.z, a0.w); w.z = pk2(a1.x, a1.y); w.w = pk2(a1.z, a1.w);
                   *(GAS v4u*)(hb_out + (size_t)m * DM + col) = w; }
        }
        if constexpr (!OUT_F32) { s2 = wave_sum(s2); if (C.lane == 0) rs[m] = rsqrtf(s2 * (1.f / DM) + EPS); }
    }
}
template <int W> __device__ __forceinline__ void pool_block(const bf16_t* up0, int sq0, bf16_t* dp0) {
    v4u v[W + 3];
#pragma unroll
    for (int i = 0; i < W + 3; ++i) { const int rel = i - (W - 1); const int off = (sq0 + rel >= 0) ? rel : 0; v[i] = *(const GAS v4u*)(up0 + (long)off * IN_PAD); }
    float S[8];
#pragma unroll
    for (int e = 0; e < 8; ++e) S[e] = 0.f;
#pragma unroll
    for (int i = 0; i < W; ++i) { const float wi = (sq0 + i - (W - 1) >= 0) ? 1.f : 0.f;
#pragma unroll
        for (int e = 0; e < 4; ++e) { S[2 * e] += wi * bflo(v[i][e]); S[2 * e + 1] += wi * bfhi(v[i][e]); } }
#pragma unroll
    for (int t = 0; t < 4; ++t) {
        if (t > 0) { const float wo = (sq0 + (t - 1) - (W - 1) >= 0) ? 1.f : 0.f;
#pragma unroll
            for (int e = 0; e < 4; ++e) { S[2 * e] += bflo(v[W - 1 + t][e]) - wo * bflo(v[t - 1][e]); S[2 * e + 1] += bfhi(v[W - 1 + t][e]) - wo * bfhi(v[t - 1][e]); } }
        const int cnt = (sq0 + t + 1) < W ? (sq0 + t + 1) : W; const float inv = 1.0f / (float)cnt;
        v4u o;
#pragma unroll
        for (int e = 0; e < 4; ++e) o[e] = pk2(S[2 * e] * inv - bflo(v[W - 1 + t][e]), S[2 * e + 1] * inv - bfhi(v[W - 1 + t][e]));
        *(GAS v4u*)(dp0 + (size_t)t * POOLW) = o;
    }
}
__device__ __forceinline__ float sumsq8(const v4u w) { float s = 0.f;
#pragma unroll
    for (int e = 0; e < 4; ++e) { const float lo = bflo(w[e]), hi = bfhi(w[e]); s += lo * lo + hi * hi; } return s; }
__device__ __forceinline__ v4u scale8(const v4u w, float r, const f32x4 g0, const f32x4 g1) {
    v4u o; o.x = pk2(bflo(w[0]) * r * g0.x, bfhi(w[0]) * r * g0.y); o.y = pk2(bflo(w[1]) * r * g0.z, bfhi(w[1]) * r * g0.w);
    o.z = pk2(bflo(w[2]) * r * g1.x, bfhi(w[2]) * r * g1.y); o.w = pk2(bflo(w[3]) * r * g1.z, bfhi(w[3]) * r * g1.w); return o; }
__device__ __forceinline__ void mixer_prep(LAS unsigned char* lds_, const bf16_t* z, const float* qn, const float* kvn, const float* tab, bf16_t* cqn, bf16_t* ckvn, unsigned char* rimg, bf16_t* dp) {
    const Ctx C = make_ctx(lds_);
    {
        const int l = C.lane; const bool two = l < 48;
        const f32x4 gq0 = *(const GAS f32x4*)(qn + 8 * l), gq1 = *(const GAS f32x4*)(qn + 8 * l + 4);
        const f32x4 gr0 = two ? *(const GAS f32x4*)(qn + 512 + 8 * l) : (f32x4){0.f, 0.f, 0.f, 0.f}, gr1 = two ? *(const GAS f32x4*)(qn + 512 + 8 * l + 4) : (f32x4){0.f, 0.f, 0.f, 0.f};
        const f32x4 gk0 = *(const GAS f32x4*)(kvn + 8 * l), gk1 = *(const GAS f32x4*)(kvn + 8 * l + 4);
        for (int m = C.gw; m < M; m += C.NGW) {
            const bf16_t* zr = z + (size_t)m * IN_PAD;
            const v4u q0 = *(const GAS v4u*)(zr + OQ + 8 * l);
            const v4u q1 = two ? *(const GAS v4u*)(zr + OQ + 512 + 8 * l) : (v4u){0u, 0u, 0u, 0u};
            const v4u kv = *(const GAS v4u*)(zr + OKV + 8 * l);
            const int i = l & 31, which = l >> 5;
            const float t1 = bf2f(zr[OROPE + i]), t2 = bf2f(zr[OROPE + 32 + i]), c = tab[(size_t)m * 64 + i], s = tab[(size_t)m * 64 + 32 + i];
            float sq_ = sumsq8(q0) + sumsq8(q1), sk_ = sumsq8(kv);
#pragma unroll
            for (int o = 1; o < 64; o <<= 1) { sq_ += __shfl_xor(sq_, o); sk_ += __shfl_xor(sk_, o); }
            const float rq = rsqrtf(sq_ * (1.f / QLR) + EPS), rk = rsqrtf(sk_ * (1.f / KVLR) + EPS);
            *(GAS v4u*)(cqn + (size_t)m * QLR + 8 * l) = scale8(q0, rq, gq0, gq1);
            if (two) *(GAS v4u*)(cqn + (size_t)m * QLR + 512 + 8 * l) = scale8(q1, rq, gr0, gr1);
            *(GAS v4u*)(ckvn + (size_t)m * KVLR + 8 * l) = scale8(kv, rk, gk0, gk1);
            const float r = which ? (t2 * c + t1 * s) : (t1 * c - t2 * s); const int d = i + 32 * which;
            const int bb = m >> 13, sq = m & (SEQ - 1), T = sq >> 6, k = sq & 63;
            *(bf16_t*)(rimg + (size_t)(bb * 128 + T) * 8192 + (d >> 3) * 1024 + k * 16 + (d & 7) * 2) = (bf16_t)f2bf(r);
        }
    }
    for (int it = C.gtid; it < (M / 4) * 256; it += C.NT) {
        const int rb = it >> 8, ch = it & 255, g = ch >> 6, r0 = 4 * rb, sq0 = r0 & (SEQ - 1);
        const bf16_t* up0 = z + (size_t)r0 * IN_PAD + OU + ch * 8; bf16_t* dp0 = dp + (size_t)r0 * POOLW + ch * 8;
        if (g == 0) pool_block<2>(up0, sq0, dp0); else if (g == 1) pool_block<4>(up0, sq0, dp0); else if (g == 2) pool_block<8>(up0, sq0, dp0); else pool_block<16>(up0, sq0, dp0);
    }
}

#ifndef ATT_REP
#define ATT_REP 1
#endif
#ifdef NO_THIN
#define THIN_CALL if (0)
#else
#define THIN_CALL
#endif
#ifdef NO_GEMM
#define GEMM_CALL if (0)
#else
#define GEMM_CALL
#endif
struct Args { const float* in[17]; float* out; unsigned char* ws; };
typedef const __attribute__((address_space(4))) Args* KArgs;
__device__ __forceinline__ KArgs kargs() { KArgs p = (KArgs)__builtin_amdgcn_kernarg_segment_ptr(); asm volatile("" : "+s"(p)); return p; }
#define KIN(k) ((const float*)kargs()->in[k])
__global__ void __launch_bounds__(NWAVES * 64, 2) fwd_kernel(Args args) {
    extern __shared__ __attribute__((aligned(16))) unsigned char lds_raw[];
    LAS unsigned char* lds = (LAS unsigned char*)lds_raw;
    const int G = gridDim.x, bx = blockIdx.x; const int vcu = (G % 8 == 0) ? (bx % 8) * (G / 8) + bx / 8 : bx;
    unsigned char* ws = kargs()->ws;
    unsigned* ctl = (unsigned*)(ws + WS_CTL);
    for (int u = threadIdx.x; u < (LDS_BYTES - LDSCTL_OFF) / 4; u += NWAVES * 64) ((LAS unsigned*)(lds + LDSCTL_OFF))[u] = 0u;
    __syncthreads();
    volatile LAS unsigned* MISC = (volatile LAS unsigned*)(lds + MISC_OFF);
    (void)xcd_barrier_post(ctl + CW_BAR, MISC + 8);

#define WSP(off) (kargs()->ws + (off))
#define GRID_BARRIER() do { XcdBarrier b_; b_.bar = (unsigned*)WSP(WS_CTL) + CW_BAR; b_.x = (unsigned)__builtin_amdgcn_readfirstlane((int)xb_xcc_id()); \
        b_.st = (volatile LAS unsigned*)(lds + MISC_OFF) + 8; xcd_barrier(b_); } while (0)
#define tab  ((float*)WSP(WS_ROPE))
#define RS   ((float*)WSP(WS_RS))
#define A    ((bf16_t*)WSP(WS_A))
#define MB   ((bf16_t*)WSP(WS_MB))
#define ACT  ((bf16_t*)WSP(WS_ACT))
#define Z    ((bf16_t*)WSP(WS_Z))
#define CQN  ((bf16_t*)WSP(WS_CQN))
#define CKVN ((bf16_t*)WSP(WS_CKVN))
#define RIMG (WSP(WS_KROPE))
#define DP   ((bf16_t*)WSP(WS_DP))
#define Q    ((bf16_t*)WSP(WS_Q))
#define KIMG (WSP(WS_KIMG))
#define VIMG (WSP(WS_VIMG))
#define CAT  ((bf16_t*)WSP(WS_CAT))
#pragma unroll 1
    for (int l = 0; l < 2; ++l) {
        WSrc S; S.w_in = KIN(2) + (size_t)l * DM * IN_DIM; S.w_q = KIN(4) + (size_t)l * QLR * QW; S.w_kv = KIN(6) + (size_t)l * KVLR * KVW; S.pool_w = KIN(7) + (size_t)l * 4 * PGD * PGD;
        S.w_out = KIN(9) + (size_t)l * DM * DM; S.w_gate = KIN(14) + (size_t)l * DM * DFF; S.w_up = KIN(15) + (size_t)l * DM * DFF; S.w_down = KIN(16) + (size_t)l * DFF * DM; S.g_mix = KIN(10) + (size_t)l * DM; S.g_ffn = KIN(12) + (size_t)l * DM;
        THIN_CALL convert_weights(lds, S, WSP(WS_W0) + (size_t)l * W_LAYER);
    }
    THIN_CALL rope_table(lds, (const int*)KIN(1), tab);
    THIN_CALL xcopy_first(lds, KIN(0), A, RS);
    GRID_BARRIER();

#pragma unroll 1
    for (int l = 0; l < 2; ++l) {
#define wl (WSP(WS_W0) + (size_t)l * W_LAYER)
        { pg8::Gemm g{A, (const bf16_t*)(wl + WO_IN), M, IN_PAD, DM, DM, 0}; pg8::StaticOrder S; S.init(M, IN_PAD, G, bx);
          pg8::EpiStore E{Z, IN_PAD, 1.0f, RS}; GEMM_CALL pg8::gemm_phase<pg8::EpiStore>(lds, g, S, E); }
        GRID_BARRIER();
        THIN_CALL mixer_prep(lds, Z, KIN(3) + (size_t)l * QLR, KIN(5) + (size_t)l * KVLR, tab, CQN, CKVN, RIMG, DP);
        GRID_BARRIER();
        { pg8::Gemm g{DP, (const bf16_t*)(wl + WO_POOL), M, POOLW, PGD, POOLW, PGD}; pg8::StaticOrder S; S.init(M, POOLW, G, bx);
          pg8::EpiPool E{CAT, KIN(8) + (size_t)l * POOLW}; GEMM_CALL pg8::gemm_phase<pg8::EpiPool>(lds, g, S, E); }
        { pg8::Gemm g{CQN, (const bf16_t*)(wl + WO_Q), M, QW, QLR, QLR, 0}; pg8::StaticOrder S; S.init(M, QW, G, bx);
          pg8::EpiStore E{Q, QW, QSCALE, nullptr}; GEMM_CALL pg8::gemm_phase<pg8::EpiStore>(lds, g, S, E); }
        { pg8::Gemm g{CKVN, (const bf16_t*)(wl + WO_KV), M, KVW, KVLR, KVLR, 0}; pg8::StaticOrder S; S.init(M, KVW, G, bx);
          pg8::EpiKV E{KIMG, VIMG}; GEMM_CALL pg8::gemm_phase<pg8::EpiKV>(lds, g, S, E); }
        GRID_BARRIER();
#ifndef NO_ATT
        {
            if (G == 256) { const int s = vcu & 7, bh = vcu >> 3;
#pragma unroll 1
                for (int i = 0; i < 4 * ATT_REP; ++i) { const int qb = ((i & 3) == 0) ? 31 - s : ((i & 3) == 1) ? 16 + s : ((i & 3) == 2) ? 15 - s : s;
                    att::attn_unit(bh >> 4, bh & 15, qb, Q, KIMG, VIMG, RIMG, tab, CAT, lds); } }
            else {
#pragma unroll 1
                for (int L = bx; L < BATCH * NH * 32; L += G) { const int bh = L >> 5, qb = 31 - (L & 31); att::attn_unit(bh >> 4, bh & 15, qb, Q, KIMG, VIMG, RIMG, tab, CAT, lds); } }
        }
#endif
        GRID_BARRIER();
        { pg8::Gemm g{CAT, (const bf16_t*)(wl + WO_OUT), M, DM, DM, DM, 0}; pg8::StaticOrder S; S.init(M, DM, G, bx);
          pg8::EpiStore E{MB, DM, 1.0f, nullptr}; GEMM_CALL pg8::gemm_phase<pg8::EpiStore>(lds, g, S, E); }
        GRID_BARRIER();
        if (l == 0) { THIN_CALL resnorm<true, false>(lds, MB, KIN(0), KIN(11), A, nullptr, RS); }
        else { THIN_CALL resnorm<false, false>(lds, MB, A, KIN(11) + DM, A, nullptr, RS); }
        GRID_BARRIER();
        { pg8::Gemm g{A, (const bf16_t*)(wl + WO_GU), M, 2 * DFF, DM, DM, 0}; pg8::StaticOrder S; S.init(M, 2 * DFF, G, bx); S.rev = 1;
          pg8::EpiSwiGLU E{ACT, RS}; GEMM_CALL pg8::gemm_phase<pg8::EpiSwiGLU>(lds, g, S, E); }
        if (G == 256) group_barrier32((unsigned*)WSP(WS_CTL) + 8192 + 64 * (blockIdx.x & 7)); else GRID_BARRIER();
        { pg8::Gemm g{ACT, (const bf16_t*)(wl + WO_DN), M, DM, DFF, DFF, 0}; pg8::StaticOrder S; S.init(M, DM, G, bx, 4);
          pg8::EpiStore E{MB, DM, 1.0f, nullptr}; GEMM_CALL pg8::gemm_phase<pg8::EpiStore>(lds, g, S, E); }
        GRID_BARRIER();
        if (l == 0) { THIN_CALL resnorm<false, false>(lds, MB, A, KIN(13), A, nullptr, RS); }
        else { THIN_CALL resnorm<false, true>(lds, MB, A, KIN(13) + DM, nullptr, kargs()->out, nullptr); }
        if (l == 0) GRID_BARRIER();
    }
}

#undef WSP
#undef tab
#undef RS
#undef A
#undef MB
#undef ACT
#undef Z
#undef CQN
#undef CKVN
#undef RIMG
#undef DP
#undef Q
#undef KIMG
#undef VIMG
#undef CAT
#undef wl
extern "C" void kernel_launch(void* const* d_in, const int* in_sizes, int n_in, void* d_out, int out_size, void* d_ws, size_t ws_size, hipStream_t stream) {
    static int grid = 0;
    if (grid == 0) {
        if (n_in != 17 || out_size != M * DM || ws_size < WS_END) { fprintf(stderr, "kernel_launch: unexpected shapes (n_in %d, out %d, ws %zu; need ws >= %zu)\n", n_in, out_size, ws_size, (size_t)WS_END); grid = -1; return; }
        int dev = 0, cus = 0, per_cu = 0;
        if (hipGetDevice(&dev) != hipSuccess || hipDeviceGetAttribute(&cus, hipDeviceAttributeMultiprocessorCount, dev) != hipSuccess) { grid = -1; return; }
        if (hipFuncSetAttribute((const void*)fwd_kernel, hipFuncAttributeMaxDynamicSharedMemorySize, LDS_BYTES) != hipSuccess) { fprintf(stderr, "kernel_launch: hipFuncSetAttribute failed\n"); grid = -1; return; }
        if (hipOccupancyMaxActiveBlocksPerMultiprocessor(&per_cu, (const void*)fwd_kernel, NWAVES * 64, LDS_BYTES) != hipSuccess || per_cu < 1)
            fprintf(stderr, "kernel_launch: note: occupancy query reports %d workgroups per CU\n", per_cu);
        (void)hipGetLastError();
        grid = cus;
    }
    if (grid < 0) return;
    (void)in_sizes;
    if (hipMemsetAsync((char*)d_ws + WS_CTL, 0, CTL_ZERO_BYTES, stream) != hipSuccess) return;
    Args a{};
    for (int i = 0; i < 17; ++i) a.in[i] = (const float*)d_in[i];
    a.out = (float*)d_out; a.ws = (unsigned char*)d_ws;
    hipLaunchKernelGGL(fwd_kernel, dim3(grid), dim3(NWAVES * 64), LDS_BYTES, stream, a);
    const hipError_t le = hipPeekAtLastError();
    if (le != hipSuccess) fprintf(stderr, "kernel_launch: launch failed: %s\n", hipGetErrorName(le));
}
```

```cpp
#include <hip/hip_runtime.h>
#include <cstdio>
#include <cstdint>

constexpr int BATCH = 2, SEQ = 8192, M = BATCH * SEQ, DM = 4096, NH = 16;
constexpr int DNOPE = 128, DROPE = 64, DQK = 192, DV = 128;
constexpr int QLR = 896, KVLR = 512, IN_DIM = 3520, IN_PAD = 3584, POOLW = 2048, PGD = 512, DFF = 11008;
constexpr int QW = NH * DQK, KVW = NH * (DNOPE + DV);
constexpr int OQ = 0, OKV = QLR, OROPE = QLR + KVLR, OU = QLR + KVLR + DROPE;
constexpr float EPS = 1e-6f;
constexpr float QSCALE = 0.07216878364870322f * 1.4426950408889634f;

constexpr size_t MiB = 1u << 20;
constexpr size_t WS_CTL = 0, CTL_ZERO_BYTES = 64 * 1024;
constexpr size_t WS_RS = 512 * 1024;
constexpr size_t WS_ROPE = 1 * MiB;
constexpr size_t WS_W0 = 8 * MiB, W_LAYER = 330 * MiB;
constexpr size_t WO_IN = 0, WO_Q = 28 * MiB, WO_KV = 34 * MiB, WO_POOL = 38 * MiB, WO_OUT = 40 * MiB, WO_GU = 72 * MiB, WO_DN = 244 * MiB;
constexpr size_t WS_A = 668 * MiB;
constexpr size_t WS_MB = 796 * MiB;
constexpr size_t WS_ACT = 924 * MiB;
constexpr size_t WS_Z = 924 * MiB;
constexpr size_t WS_CQN = 1036 * MiB;
constexpr size_t WS_CKVN = 1064 * MiB;
constexpr size_t WS_KROPE = 1080 * MiB;
constexpr size_t WS_DP = 1082 * MiB;
constexpr size_t WS_Q = 1146 * MiB;
constexpr size_t WS_KIMG = 1268 * MiB;
constexpr size_t WS_VIMG = 1332 * MiB;
constexpr size_t WS_CAT = 1396 * MiB;
constexpr size_t WS_END = 1524 * MiB;
static_assert(WS_Q + (size_t)M * QW * 2 <= WS_ACT + (size_t)M * DFF * 2 && WS_ACT + (size_t)M * DFF * 2 <= WS_KIMG, "ws map");

constexpr int CW_TMO = 0, CW_BAR = 4096;

constexpr int RING_BYTES = 131072, LDSCTL_OFF = RING_BYTES, MISC_OFF = LDSCTL_OFF + 320, LDS_BYTES = 147456;
constexpr int NWAVES = 8;

#define GAS __attribute__((address_space(1)))
#define LAS __attribute__((address_space(3)))
typedef unsigned short bf16_t;
typedef unsigned v4u __attribute__((ext_vector_type(4)));
typedef unsigned v2u __attribute__((ext_vector_type(2)));
typedef float f32x4 __attribute__((ext_vector_type(4)));
typedef float f32x16 __attribute__((ext_vector_type(16)));
typedef short bf16x8 __attribute__((ext_vector_type(8)));
typedef short s16x4 __attribute__((ext_vector_type(4)));
#define LDS_WAIT() asm volatile("s_waitcnt lgkmcnt(0)" ::: "memory")

__device__ __forceinline__ unsigned cvt_pk_bf16(float lo, float hi) { unsigned r; asm volatile("v_cvt_pk_bf16_f32 %0, %1, %2" : "=v"(r) : "v"(lo), "v"(hi)); return r; }
__device__ __forceinline__ unsigned f2bf(float f) { unsigned u = __builtin_bit_cast(unsigned, f); return (u + 0x7fffu + ((u >> 16) & 1u)) >> 16; }
__device__ __forceinline__ unsigned pk2(float lo, float hi) { return f2bf(lo) | (f2bf(hi) << 16); }
__device__ __forceinline__ float bflo(unsigned w) { return __uint_as_float(w << 16); }
__device__ __forceinline__ float bfhi(unsigned w) { return __uint_as_float(w & 0xffff0000u); }
__device__ __forceinline__ float bf2f(unsigned short b) { return __uint_as_float(((unsigned)b) << 16); }
__device__ __forceinline__ float wave_sum(float v) {
#pragma unroll
    for (int o = 1; o < 64; o <<= 1) v += __shfl_xor(v, o);
    return v;
}

namespace pg8 {
#define PG8_LAS __attribute__((address_space(3)))
typedef unsigned u32x4 __attribute__((ext_vector_type(4)));
constexpr int BM = 256, BK = 64, HALF = 128, HTB = HALF * BK * 2, STAGE_BYTES = 8 * HTB, NXCD = 8, WGM = 8;

__host__ __device__ __forceinline__ int lds_byte(int r, int c) { const int st = (r >> 4) * 2 + (c >> 5), rr = r & 15, cc = c & 31, ob = rr * 64 + cc * 2; return st * 1024 + (ob ^ (((ob >> 9) & 1) << 5)); }
__host__ __device__ __forceinline__ void stage_rc(int b, int& R, int& C) { const int st = b / 1024, sb = b % 1024, swz = sb ^ (((sb >> 9) & 1) << 5); R = (st >> 1) * 16 + swz / 64; C = (st & 1) * 32 + (swz % 64) / 2; }
__host__ __device__ __forceinline__ int perm32(int rho) { const int n = rho >> 4, i = rho & 15; return 8 * (i >> 2) + 4 * n + (i & 3); }

struct Unit { int pm, pn; };
struct Gemm { const bf16_t* A; const bf16_t* Bt; int M, N, K, lda, agrp; };

struct StaticOrder {
    int nM, nN, nwg, G, c, wgm, rev = 0, pair = 0;
    __host__ __device__ void init(int M_, int N_, int G_, int c_, int wgm_ = WGM) { nM = M_ / BM; nN = N_ / BM; nwg = nM * nN; G = G_; c = c_; wgm = wgm_; }
    __host__ __device__ bool next(int i, Unit& u) const {
        const long L = (long)i * G + c; if (L >= nwg) return false;
        if (pair) {
            const int xcd = (int)(L % NXCD), off = (int)(L / NXCD), gid = off >> 5, w = off & 31;
            u.pm = 16 * (xcd >> 1) + 4 * gid + (w & 3); u.pn = 8 * (xcd & 1) + (w >> 2); return true; }
        int wgid = (int)L; { const int q = nwg / NXCD, r = nwg % NXCD, xcd = wgid % NXCD, off = wgid / NXCD; wgid = (xcd < r ? xcd * (q + 1) : r * (q + 1) + (xcd - r) * q) + off; }
        const int nig = wgm * nN, gid = wgid / nig, fm = gid * wgm, gsz = (nM - fm) < wgm ? (nM - fm) : wgm;
        u.pm = fm + ((wgid % nig) % gsz); u.pn = (wgid % nig) / gsz; if (rev) u.pn = nN - 1 - u.pn; return true;
    }
};

__device__ __forceinline__ u32x4 pack8(const f32x4 a, const f32x4 b) { u32x4 w; w.x = cvt_pk_bf16(a[0], a[1]); w.y = cvt_pk_bf16(a[2], a[3]); w.z = cvt_pk_bf16(b[0], b[1]); w.w = cvt_pk_bf16(b[2], b[3]); return w; }

struct EpiStore {
    static constexpr bool PERM = true;
    bf16_t* O; int ldc; float scale; const float* rs;
    __device__ __forceinline__ void operator()(const f32x4 (&acc)[2][2][4][2], const Unit& u, int wr, int wc, int fr, int fq) const {
        const int row0 = u.pm * BM + wr * 64 + fr, col0 = u.pn * BM + wc * 32 + 8 * fq;
#pragma unroll
        for (int ai = 0; ai < 2; ++ai)
#pragma unroll
            for (int m = 0; m < 4; ++m) { const int row = row0 + ai * HALF + m * 16; bf16_t* rowp = O + (size_t)row * ldc + col0;
                const float s = rs ? scale * rs[row] : scale;
#pragma unroll
                for (int bj = 0; bj < 2; ++bj) *(u32x4*)(rowp + bj * HALF) = pack8(acc[ai][bj][m][0] * s, acc[ai][bj][m][1] * s); }
    }
};
struct EpiPool {
    static constexpr bool PERM = true;
    bf16_t* O; const float* ps;
    __device__ __forceinline__ void operator()(const f32x4 (&acc)[2][2][4][2], const Unit& u, int wr, int wc, int fr, int fq) const {
        const int row0 = u.pm * BM + wr * 64 + fr, col0 = u.pn * BM + wc * 32 + 8 * fq;
        f32x4 sv[2][2];
#pragma unroll
        for (int bj = 0; bj < 2; ++bj)
#pragma unroll
            for (int n = 0; n < 2; ++n) sv[bj][n] = *(const f32x4*)(ps + col0 + bj * HALF + 4 * n);
#pragma unroll
        for (int ai = 0; ai < 2; ++ai)
#pragma unroll
            for (int m = 0; m < 4; ++m) { bf16_t* rowp = O + (size_t)(row0 + ai * HALF + m * 16) * DM + POOLW + col0;
#pragma unroll
                for (int bj = 0; bj < 2; ++bj) *(u32x4*)(rowp + bj * HALF) = pack8(acc[ai][bj][m][0] * sv[bj][0], acc[ai][bj][m][1] * sv[bj][1]); }
    }
};
struct EpiKV {
    static constexpr bool PERM = true;
    unsigned char* kimg; unsigned char* vimg;
    __device__ __forceinline__ void operator()(const f32x4 (&acc)[2][2][4][2], const Unit& u, int wr, int wc, int fr, int fq) const {
        const int b = u.pm >> 5, pmm = u.pm & 31, h = u.pn;
#pragma unroll
        for (int ai = 0; ai < 2; ++ai)
#pragma unroll
            for (int m = 0; m < 4; ++m) {
                const int T = pmm * 4 + 2 * ai + wr, k = 16 * m + fr;
                const size_t tile = (size_t)((b * NH + h) * 128 + T) * 16384;
                *(u32x4*)(kimg + tile + (4 * wc + fq) * 1024 + k * 16) = pack8(acc[ai][0][m][0], acc[ai][0][m][1]);
                const int kk = k;
                *(u32x4*)(vimg + tile + ((kk >> 3) * 4 + wc) * 512 + ((kk & 7) * 32 + 8 * fq) * 2) = pack8(acc[ai][1][m][0], acc[ai][1][m][1]);
            }
    }
};
struct EpiSwiGLU {
    static constexpr bool PERM = true;
    bf16_t* O; const float* rs;
    __device__ __forceinline__ static float silu_mul(float g, float u) { const float e = __builtin_amdgcn_exp2f(g * -1.4426950408889634f); return g * __builtin_amdgcn_rcpf(1.0f + e) * u; }
    __device__ __forceinline__ void operator()(const f32x4 (&acc)[2][2][4][2], const Unit& u, int wr, int wc, int fr, int fq) const {
        const int row0 = u.pm * BM + wr * 64 + fr, col0 = u.pn * HALF + wc * 32 + 8 * fq;
#pragma unroll
        for (int ai = 0; ai < 2; ++ai)
#pragma unroll
            for (int m = 0; m < 4; ++m) { const int row = row0 + ai * HALF + m * 16; bf16_t* rowp = O + (size_t)row * DFF + col0;
                const float s = rs[row];
                f32x4 v0, v1;
#pragma unroll
                for (int j = 0; j < 4; ++j) { v0[j] = silu_mul(acc[ai][0][m][0][j] * s, acc[ai][1][m][0][j] * s); v1[j] = silu_mul(acc[ai][0][m][1][j] * s, acc[ai][1][m][1][j] * s); }
                *(u32x4*)rowp = pack8(v0, v1); }
    }
};

template <class Epi, bool ALIGN_EPI = true, bool SP2 = true>
__device__ __forceinline__ void gemm_phase(PG8_LAS unsigned char* lds, const Gemm g, const StaticOrder& S, const Epi& E) {
    int tid = threadIdx.x; asm volatile("" : "+v"(tid));
    const int wid = __builtin_amdgcn_readfirstlane(tid >> 6), lane = tid & 63, wr = wid >> 2, wc = wid & 3, fr = lane & 15, fq = lane >> 4;
    const int K = g.K, nt = K / BK, lda = g.lda;
    unsigned voffA[2], voffB[2];
#pragma unroll
    for (int i = 0; i < 2; ++i) { int R, C; stage_rc(tid * 16 + i * 8192, R, C); const int Rb = Epi::PERM ? ((R & ~31) + perm32(R & 31)) : R;
        voffA[i] = (unsigned)(R * lda + C) * 2u; voffB[i] = (unsigned)(Rb * K + C) * 2u; }
    const size_t kstep = (size_t)(BK * 2);
    const size_t hstepA = (size_t)HALF * lda * 2, hstepB = (size_t)HALF * K * 2;
    const size_t tstepA = 2 * hstepA, tstepB = 2 * hstepB;
    const unsigned ldsw = (unsigned)wid * 1024u;
    const int aoff = lds_byte(wr * 64 + fr, fq * 8), boff = lds_byte(wc * 32 + fr, fq * 8);
#define PG8_SA(b, h) (((b) * 2 + (h)) * HTB)
#define PG8_SB(b, h) ((4 + (b) * 2 + (h)) * HTB)
#define PG8_STAGE(bufoff, gbase, voff) do { _Pragma("unroll") for (int _i = 0; _i < 2; ++_i) \
        __builtin_amdgcn_global_load_lds((const unsigned*)((const char*)(gbase) + (voff)[_i]), (PG8_LAS unsigned*)(lds + (bufoff) + ldsw + _i * 8192), 16, 0, 0); } while (0)
#define PG8_LDA(dst, b, h) do { _Pragma("unroll") for (int m = 0; m < 4; ++m) _Pragma("unroll") for (int k = 0; k < 2; ++k) dst[m][k] = *(const PG8_LAS bf16x8*)(lds + PG8_SA(b, h) + aoff + m * 2048 + k * 1024); } while (0)
#define PG8_LDB(dst, b, h) do { _Pragma("unroll") for (int n = 0; n < 2; ++n) _Pragma("unroll") for (int k = 0; k < 2; ++k) dst[n][k] = *(const PG8_LAS bf16x8*)(lds + PG8_SB(b, h) + boff + n * 2048 + k * 1024); } while (0)
#define PG8_MMA(ai, bj, At, Bt) do { __builtin_amdgcn_s_setprio(1); _Pragma("unroll") for (int m = 0; m < 4; ++m) _Pragma("unroll") for (int n = 0; n < 2; ++n) _Pragma("unroll") for (int k = 0; k < 2; ++k) \
        acc[ai][bj][m][n] = __builtin_amdgcn_mfma_f32_16x16x32_bf16(Bt[n][k], At[m][k], acc[ai][bj][m][n], 0, 0, 0); __builtin_amdgcn_s_setprio(0); } while (0)
#define PG8_WAIT_V(n) asm volatile("s_waitcnt vmcnt(" #n ")" ::: "memory")
#define PG8_WAIT_L(n) asm volatile("s_waitcnt lgkmcnt(" #n ")" ::: "memory")
#define PG8_BAR __builtin_amdgcn_s_barrier()
#define PG8_SCHED __builtin_amdgcn_sched_barrier(0)
    Unit cur, nxt; int ui = 0;
    if (!S.next(0, cur)) return;
    f32x4 acc[2][2][4][2];
#pragma unroll
    for (int a = 0; a < 2; ++a)
#pragma unroll
        for (int b = 0; b < 2; ++b)
#pragma unroll
            for (int m = 0; m < 4; ++m)
#pragma unroll
                for (int n = 0; n < 2; ++n) acc[a][b][m][n] = (f32x4){0.f, 0.f, 0.f, 0.f};
    bf16x8 At[4][2], B0[2][2], B1[2][2];
    const char* cA = (const char*)g.A + (size_t)cur.pm * tstepA + (size_t)((cur.pn >> 1) * g.agrp) * 2; const char* cB = (const char*)g.Bt + (size_t)cur.pn * tstepB;
    if constexpr (SP2) {
        PG8_STAGE(PG8_SB(0, 0), cB, voffB); PG8_STAGE(PG8_SB(0, 1), cB + hstepB, voffB); PG8_STAGE(PG8_SA(0, 0), cA, voffA); PG8_STAGE(PG8_SA(0, 1), cA + hstepA, voffA);
        if (wr == 1) PG8_BAR;
        PG8_WAIT_V(2); PG8_BAR;
        PG8_STAGE(PG8_SB(1, 0), cB + kstep, voffB); PG8_STAGE(PG8_SA(1, 0), cA + kstep, voffA); PG8_STAGE(PG8_SB(1, 1), cB + hstepB + kstep, voffB);
        PG8_WAIT_V(6); PG8_BAR;
    } else {
        PG8_STAGE(PG8_SB(0, 0), cB, voffB); PG8_STAGE(PG8_SA(0, 0), cA, voffA); PG8_STAGE(PG8_SB(0, 1), cB + hstepB, voffB); PG8_STAGE(PG8_SA(0, 1), cA + hstepA, voffA);
        if (wr == 1) PG8_BAR;
        PG8_WAIT_V(4); PG8_BAR;
        PG8_STAGE(PG8_SB(1, 0), cB + kstep, voffB); PG8_STAGE(PG8_SA(1, 0), cA + kstep, voffA); PG8_STAGE(PG8_SB(1, 1), cB + hstepB + kstep, voffB);
        PG8_WAIT_V(6); PG8_BAR;
    }
    for (;;) {
        const bool has_next = S.next(ui + 1, nxt);
        const char* nA = has_next ? (const char*)g.A + (size_t)nxt.pm * tstepA + (size_t)((nxt.pn >> 1) * g.agrp) * 2 : cA; const char* nB = has_next ? (const char*)g.Bt + (size_t)nxt.pn * tstepB : cB;
        for (int t = 0; t < nt; t += 2) {
            const bool last = (t == nt - 2);
            const char* a1 = cA + (size_t)(t + 1) * kstep;
            const char* a2 = last ? nA : cA + (size_t)(t + 2) * kstep; const char* b2 = last ? nB : cB + (size_t)(t + 2) * kstep;
            const char* a3 = a2 + kstep; const char* b3 = b2 + kstep;
            if constexpr (SP2) {
            PG8_LDB(B0, 0, 0); PG8_LDB(B1, 0, 1); PG8_SCHED; PG8_LDA(At, 0, 0); PG8_STAGE(PG8_SA(1, 1), a1 + hstepA, voffA);
            PG8_WAIT_V(8); PG8_WAIT_L(0); PG8_BAR; PG8_MMA(0, 0, At, B0); PG8_MMA(0, 1, At, B1); PG8_BAR; PG8_SCHED;
            PG8_LDA(At, 0, 1); PG8_STAGE(PG8_SB(0, 0), b2, voffB); PG8_STAGE(PG8_SB(0, 1), b2 + hstepB, voffB); PG8_STAGE(PG8_SA(0, 0), a2, voffA);
            PG8_WAIT_V(8); PG8_WAIT_L(0); PG8_BAR; PG8_MMA(1, 0, At, B0); PG8_MMA(1, 1, At, B1); PG8_BAR; PG8_SCHED;
            PG8_LDB(B0, 1, 0); PG8_LDB(B1, 1, 1); PG8_SCHED; PG8_LDA(At, 1, 0); PG8_STAGE(PG8_SA(0, 1), a2 + hstepA, voffA);
            PG8_WAIT_V(8); PG8_WAIT_L(0); PG8_BAR; PG8_MMA(0, 0, At, B0); PG8_MMA(0, 1, At, B1); PG8_BAR; PG8_SCHED;
            PG8_LDA(At, 1, 1); PG8_STAGE(PG8_SB(1, 0), b3, voffB); PG8_STAGE(PG8_SB(1, 1), b3 + hstepB, voffB); PG8_STAGE(PG8_SA(1, 0), a3, voffA);
            PG8_WAIT_V(8); PG8_WAIT_L(0); PG8_BAR; PG8_MMA(1, 0, At, B0); PG8_MMA(1, 1, At, B1); PG8_BAR; PG8_SCHED;
            } else {
            PG8_LDB(B0, 0, 0); PG8_SCHED; PG8_LDA(At, 0, 0); PG8_STAGE(PG8_SA(1, 1), a1 + hstepA, voffA);
            PG8_WAIT_L(8); PG8_BAR; PG8_WAIT_L(0); PG8_MMA(0, 0, At, B0); PG8_BAR; PG8_SCHED;
            PG8_LDB(B1, 0, 1); PG8_STAGE(PG8_SB(0, 0), b2, voffB);
            PG8_BAR; PG8_WAIT_L(0); PG8_MMA(0, 1, At, B1); PG8_BAR;
            PG8_LDA(At, 0, 1); PG8_STAGE(PG8_SA(0, 0), a2, voffA);
            PG8_BAR; PG8_WAIT_L(0); PG8_MMA(1, 0, At, B0); PG8_BAR; PG8_SCHED;
            PG8_STAGE(PG8_SB(0, 1), b2 + hstepB, voffB);
            PG8_WAIT_V(6); PG8_BAR; PG8_MMA(1, 1, At, B1); PG8_BAR;
            PG8_LDB(B0, 1, 0); PG8_SCHED; PG8_LDA(At, 1, 0); PG8_STAGE(PG8_SA(0, 1), a2 + hstepA, voffA);
            PG8_WAIT_L(8); PG8_BAR; PG8_WAIT_L(0); PG8_MMA(0, 0, At, B0); PG8_BAR; PG8_SCHED;
            PG8_LDB(B1, 1, 1); PG8_STAGE(PG8_SB(1, 0), b3, voffB);
            PG8_BAR; PG8_WAIT_L(0); PG8_MMA(0, 1, At, B1); PG8_BAR;
            PG8_LDA(At, 1, 1); PG8_STAGE(PG8_SA(1, 0), a3, voffA);
            PG8_BAR; PG8_WAIT_L(0); PG8_MMA(1, 0, At, B0); PG8_BAR; PG8_SCHED;
            PG8_STAGE(PG8_SB(1, 1), b3 + hstepB, voffB);
            PG8_WAIT_V(6); PG8_BAR; PG8_MMA(1, 1, At, B1); PG8_BAR;
            }
        }
        if constexpr (ALIGN_EPI) { if (wr == 0) PG8_BAR; }
        E(acc, cur, wr, wc, fr, fq);
        if (!has_next) break;
#pragma unroll
        for (int a = 0; a < 2; ++a)
#pragma unroll
            for (int b = 0; b < 2; ++b)
#pragma unroll
                for (int m = 0; m < 4; ++m)
#pragma unroll
                    for (int n = 0; n < 2; ++n) acc[a][b][m][n] = (f32x4){0.f, 0.f, 0.f, 0.f};
        cur = nxt; cA = nA; cB = nB; ++ui;
        if constexpr (ALIGN_EPI) { if (wr == 1) PG8_BAR; }
    }
    PG8_WAIT_V(0);
    if constexpr (!ALIGN_EPI) { if (wr == 0) PG8_BAR; }
    PG8_BAR;
#undef PG8_SA
#undef PG8_SB
#undef PG8_STAGE
#undef PG8_LDA
#undef PG8_LDB
#undef PG8_MMA
#undef PG8_WAIT_V
#undef PG8_WAIT_L
#undef PG8_BAR
#undef PG8_SCHED
}
}

namespace att {
typedef float f32x2_c __attribute__((ext_vector_type(2)));
typedef __bf16 bf16x2_c __attribute__((ext_vector_type(2)));
__device__ __forceinline__ unsigned cvt_pk(float lo, float hi) { f32x2_c v = {lo, hi}; bf16x2_c b = __builtin_convertvector(v, bf16x2_c); return __builtin_bit_cast(unsigned, b); }
constexpr int SLOTB = 40960, NSLOT = 3, ROFF = 16384, VOFF = 24576, LDS_WS = NSLOT * SLOTB, ATT_LDS_BYTES = LDS_WS + NWAVES * 256;
static_assert(ATT_LDS_BYTES <= RING_BYTES, "attention LDS");
#define SBAR() __builtin_amdgcn_sched_barrier(0)
__device__ __forceinline__ void glds16(const void* gsrc, unsigned lds_dst) { unsigned keep;
    asm volatile("s_mov_b32 %0, m0\n\ts_mov_b32 m0, %2\n\ts_nop 0\n\tglobal_load_lds_dwordx4 %1, off\n\ts_mov_b32 m0, %0" : "=&s"(keep) : "v"(gsrc), "s"(lds_dst) : "memory"); }
#define ATT_WAIT_BAR(N) asm volatile("s_waitcnt vmcnt(" #N ") lgkmcnt(0)\n\ts_barrier" ::: "memory")
typedef __attribute__((address_space(3))) const unsigned char* lds_cptr;
typedef __attribute__((address_space(3))) const bf16x8* lds_b128p;
typedef float f32x4_t __attribute__((ext_vector_type(4)));
#define MFMA16(X, Y, C) __builtin_amdgcn_mfma_f32_16x16x32_bf16(X, Y, C, 0, 0, 0)
constexpr float PLIM = 16384.f;
__device__ __forceinline__ float fadd_s(float a, float b) { float r; asm("v_add_f32_e32 %0, %1, %2" : "=v"(r) : "v"(a), "v"(b)); return r; }

__device__ __forceinline__ void cmask(f32x4 (&s)[4][2], int jb, int qrel0, int g) {
    const float NEG = -__builtin_inff();
#pragma unroll
    for (int kb = 0; kb < 4; ++kb)
#pragma unroll
        for (int r = 0; r < 4; ++r) { const int kv = 64 * jb + 16 * kb + 4 * g + r; if (kv > qrel0) s[kb][0][r] = NEG; if (kv > qrel0 + 16) s[kb][1][r] = NEG; }
}
#define ATT_KLD(dst, ks) do { _Pragma("unroll") for (int kb = 0; kb < 4; ++kb) dst[kb] = *(lds_b128p)(kb_ + (ks) * 4096 + kb * 256); } while (0)
#define ATT_KMM(src, ks) do { _Pragma("unroll") for (int kb = 0; kb < 4; ++kb) { s[kb][0] = MFMA16(src[kb], qr[0][ks], s[kb][0]); s[kb][1] = MFMA16(src[kb], qr[1][ks], s[kb][1]); } } while (0)
__device__ __forceinline__ void qkt(f32x4 (&s)[4][2], lds_cptr kb_, const bf16x8 (&qr)[2][6], const f32x4 (&negm)[2]) {
    bf16x8 ka[4], kc[4];
    ATT_KLD(ka, 0); ATT_KLD(kc, 1); SBAR();
#pragma unroll
    for (int kb = 0; kb < 4; ++kb) { s[kb][0] = MFMA16(ka[kb], qr[0][0], negm[0]); s[kb][1] = MFMA16(ka[kb], qr[1][0], negm[1]); }
    SBAR(); ATT_KLD(ka, 2); SBAR();
    ATT_KMM(kc, 1); SBAR(); ATT_KLD(kc, 3); SBAR();
    ATT_KMM(ka, 2); SBAR(); ATT_KLD(ka, 4); SBAR();
    ATT_KMM(kc, 3); SBAR(); ATT_KLD(kc, 5); SBAR();
    ATT_KMM(ka, 4); SBAR();
    ATT_KMM(kc, 5);
}
#undef ATT_KLD
#undef ATT_KMM
#define ATT_PACK() do { _Pragma("unroll") for (int qb = 0; qb < 2; ++qb) _Pragma("unroll") for (int h2 = 0; h2 < 2; ++h2) { \
        v4u w = {cvt_pk(s[2 * h2][qb][0], s[2 * h2][qb][1]), cvt_pk(s[2 * h2][qb][2], s[2 * h2][qb][3]), cvt_pk(s[2 * h2 + 1][qb][0], s[2 * h2 + 1][qb][1]), cvt_pk(s[2 * h2 + 1][qb][2], s[2 * h2 + 1][qb][3])}; \
        pa[qb][h2] = __builtin_bit_cast(bf16x8, w); } } while (0)
__device__ __forceinline__ bool softmax_fast(f32x4 (&s)[4][2], float (&l_reg)[2], bf16x8 (&pa)[2][2]) {
#pragma unroll
    for (int kb = 0; kb < 4; ++kb)
#pragma unroll
        for (int qb = 0; qb < 2; ++qb)
#pragma unroll
            for (int r = 0; r < 4; ++r) s[kb][qb][r] = __builtin_amdgcn_exp2f(s[kb][qb][r]);
    float ps0 = s[0][0][0];
#pragma unroll
    for (int kb = 0; kb < 4; ++kb)
#pragma unroll
        for (int r = 0; r < 4; ++r) if (kb + r > 0) ps0 += s[kb][0][r];
    float ps1 = s[0][1][0]; asm volatile("" : "+v"(ps0), "+v"(ps1));
#pragma unroll
    for (int kb = 0; kb < 4; ++kb)
#pragma unroll
        for (int r = 0; r < 4; ++r) if (kb + r > 0) ps1 += s[kb][1][r];
    if (__builtin_expect(!__all(ps0 <= PLIM && ps1 <= PLIM), 0)) return false;
    l_reg[0] += ps0; l_reg[1] += ps1;
    ATT_PACK();
    return true;
}
__device__ __forceinline__ void softmax_exact(f32x4 (&s)[4][2], float (&mref)[2], f32x4 (&negm)[2], bool first, float (&l_reg)[2], float (&alpha)[2], bf16x8 (&pa)[2][2]) {
#pragma unroll
    for (int qb = 0; qb < 2; ++qb) {
        float pmax = s[0][qb][0];
#pragma unroll
        for (int kb = 0; kb < 4; ++kb)
#pragma unroll
            for (int r = 0; r < 4; ++r) pmax = fmaxf(pmax, s[kb][qb][r]);
        pmax = fmaxf(pmax, __shfl_xor(pmax, 16)); pmax = fmaxf(pmax, __shfl_xor(pmax, 32));
        const float d = first ? pmax : fmaxf(pmax, 0.f); alpha[qb] = first ? 1.f : __builtin_amdgcn_exp2f(-d); mref[qb] += d;
        const float nm = -mref[qb]; negm[qb] = (f32x4){nm, nm, nm, nm};
        float ps = 0.f;
#pragma unroll
        for (int kb = 0; kb < 4; ++kb)
#pragma unroll
            for (int r = 0; r < 4; ++r) { s[kb][qb][r] = __builtin_amdgcn_exp2f(s[kb][qb][r] - d); ps += s[kb][qb][r]; }
        l_reg[qb] = l_reg[qb] * alpha[qb] + ps;
    }
    asm volatile("" : "+v"(negm[0]), "+v"(negm[1]));
    ATT_PACK();
}
#undef ATT_PACK
typedef short v4i16_t __attribute__((ext_vector_type(4)));
__device__ __forceinline__ s16x4 vtr(lds_cptr p) { return __builtin_bit_cast(s16x4, __builtin_amdgcn_ds_read_tr16_b64_v4i16((__attribute__((address_space(3))) v4i16_t*)p)); }
#define ATT_VLD(L, H, n) do { _Pragma("unroll") for (int c = 0; c < 4; ++c) { const int cb = 4 * ((n) & 1) + c; L[c] = vtr(vp + ((n) >> 1) * 8192 + (cb >> 1) * 512 + (cb & 1) * 32); H[c] = vtr(vp + ((n) >> 1) * 8192 + 4096 + (cb >> 1) * 512 + (cb & 1) * 32); } } while (0)
#define ATT_VFR(L, H, c) (bf16x8){L[c][0], L[c][1], L[c][2], L[c][3], H[c][0], H[c][1], H[c][2], H[c][3]}
#define ATT_VMM(L, H, n) do { _Pragma("unroll") for (int c = 0; c < 4; ++c) { const int cb = 4 * ((n) & 1) + c; o[cb][0] = MFMA16(ATT_VFR(L, H, c), pa[0][(n) >> 1], o[cb][0]); o[cb][1] = MFMA16(ATT_VFR(L, H, c), pa[1][(n) >> 1], o[cb][1]); } } while (0)
__device__ __forceinline__ void pv_tile(f32x4 (&o)[8][2], lds_cptr vp, const bf16x8 (&pa)[2][2]) {
    s16x4 la[4], ha[4], lb[4], hb[4];
    ATT_VLD(la, ha, 0); ATT_VLD(lb, hb, 1); SBAR();
    ATT_VMM(la, ha, 0); SBAR(); ATT_VLD(la, ha, 2); SBAR();
    ATT_VMM(lb, hb, 1); SBAR(); ATT_VLD(lb, hb, 3); SBAR();
    ATT_VMM(la, ha, 2); SBAR();
    ATT_VMM(lb, hb, 3);
}
#undef ATT_VLD
#undef ATT_VFR
#undef ATT_VMM

__device__ __forceinline__ void attn_unit(int b, int h, int qb_, const bf16_t* Q, const unsigned char* kimg, const unsigned char* vimg, const unsigned char* rimg,
                                          const float* tab, bf16_t* O, LAS unsigned char* lds) {
    int tid = threadIdx.x; asm volatile("" : "+v"(tid));
    const int lane = tid & 63, l15 = lane & 15, g = lane >> 4; const int wid = __builtin_amdgcn_readfirstlane(tid >> 6);
    const int q0 = qb_ * 256; const long rowbase = (long)b * SEQ;
    const int NT = 4 * (qb_ + 1);
    const unsigned lds0 = (unsigned)(uintptr_t)lds;
    const unsigned char* kp = kimg + (size_t)((b * NH + h) * 128) * 16384 + (size_t)(2 * wid) * 1024 + lane * 16;
    const unsigned char* vp = vimg + (size_t)((b * NH + h) * 128) * 16384 + (size_t)(2 * wid) * 1024 + lane * 16;
    const unsigned char* rp = rimg + (size_t)(b * 128) * 8192 + (size_t)wid * 1024 + lane * 16;
#define DMA_TILE(T, slotoff) do { const unsigned d_ = (unsigned)__builtin_amdgcn_readfirstlane((int)(lds0 + (unsigned)(slotoff) + (unsigned)(2 * wid) * 1024u)); \
        const unsigned dr_ = (unsigned)__builtin_amdgcn_readfirstlane((int)(lds0 + (unsigned)(slotoff) + (unsigned)ROFF + (unsigned)wid * 1024u)); \
        const unsigned char* k_ = kp + (size_t)(T) * 16384; const unsigned char* v_ = vp + (size_t)(T) * 16384; \
        glds16(k_, d_); glds16(k_ + 1024, d_ + 1024u); glds16(rp + (size_t)(T) * 8192, dr_); glds16(v_, d_ + (unsigned)VOFF); glds16(v_ + 1024, d_ + (unsigned)VOFF + 1024u); } while (0)
    DMA_TILE(0, 0);
    bf16x8 qr[2][6];
#pragma unroll
    for (int qb = 0; qb < 2; ++qb) {
        const long qrow = rowbase + q0 + wid * 32 + 16 * qb + l15;
        const bf16_t* Qw = Q + qrow * QW + h * DQK;
#pragma unroll
        for (int ks = 0; ks < 6; ++ks) qr[qb][ks] = *(const bf16x8*)(Qw + ks * 32 + g * 8);
        const float* tr = tab + qrow * 64 + 8 * g;
        const f32x4 c0 = *(const f32x4*)(tr), c1 = *(const f32x4*)(tr + 4), s0 = *(const f32x4*)(tr + 32), s1 = *(const f32x4*)(tr + 36);
        const bf16x8 x1 = qr[qb][4], x2 = qr[qb][5];
        float o1[8], o2[8];
#pragma unroll
        for (int e = 0; e < 8; ++e) { const float a = bf2f((unsigned short)x1[e]), bb = bf2f((unsigned short)x2[e]); const float c = e < 4 ? c0[e & 3] : c1[e & 3], s = e < 4 ? s0[e & 3] : s1[e & 3];
            o1[e] = a * c - bb * s; o2[e] = bb * c + a * s; }
        v4u w1 = {cvt_pk(o1[0], o1[1]), cvt_pk(o1[2], o1[3]), cvt_pk(o1[4], o1[5]), cvt_pk(o1[6], o1[7])};
        v4u w2 = {cvt_pk(o2[0], o2[1]), cvt_pk(o2[2], o2[3]), cvt_pk(o2[4], o2[5]), cvt_pk(o2[6], o2[7])};
        qr[qb][4] = __builtin_bit_cast(bf16x8, w1); qr[qb][5] = __builtin_bit_cast(bf16x8, w2);
    }
#pragma unroll
    for (int qb = 0; qb < 2; ++qb)
#pragma unroll
        for (int ks = 0; ks < 6; ++ks) asm volatile("" : "+v"(qr[qb][ks]));
    float mref[2] = {0.f, 0.f}, l_reg[2] = {0.f, 0.f}; f32x4 o[8][2];
#pragma unroll
    for (int cb = 0; cb < 8; ++cb) { o[cb][0] = (f32x4){0.f, 0.f, 0.f, 0.f}; o[cb][1] = (f32x4){0.f, 0.f, 0.f, 0.f}; }
    f32x4 negm[2] = {(f32x4){0.f, 0.f, 0.f, 0.f}, (f32x4){0.f, 0.f, 0.f, 0.f}}; asm volatile("" : "+v"(negm[0]), "+v"(negm[1]));
    const int qrel0 = wid * 32 + l15;
    const lds_cptr kb0 = (lds_cptr)lds + g * 1024 + l15 * 16;
    const lds_cptr vb00 = (lds_cptr)lds + VOFF + (g >> 1) * 2048 + (g & 1) * 256 + (l15 >> 2) * 64 + (lane & 3) * 8;
    const bool young = wid >= 4;
    int sl = 0, sn = SLOTB;
    if (young) __builtin_amdgcn_s_setprio(1);
    ATT_WAIT_BAR(0);
    if (NT > 1) { DMA_TILE(1, sn); } sn = 2 * SLOTB;
#define ATT_STEP_BAR(t) do { ATT_WAIT_BAR(0); if ((t) + 2 < NT) { DMA_TILE((t) + 2, sn); } sn = (sn == (NSLOT - 1) * SLOTB) ? 0 : sn + SLOTB; } while (0)
#pragma unroll 1
    for (int t = 0; t < NT; ++t) {
        const bool live = !(t >= NT - 4 && 64 * (t - (NT - 4)) > 32 * wid + 31);
        if (live) {
            f32x4 s[4][2]; float alpha[2]; bf16x8 pa[2][2];
            qkt(s, kb0 + sl, qr, negm);
            const bool msk = t >= NT - 4 && 64 * (t - (NT - 4)) + 63 > 32 * wid;
            if (msk) cmask(s, t - (NT - 4), qrel0, g);
            bool redo = (t == 0);
            if (!redo) { redo = !softmax_fast(s, l_reg, pa);
                if (__builtin_expect(redo, 0)) { qkt(s, kb0 + sl, qr, negm); if (msk) cmask(s, t - (NT - 4), qrel0, g); } }
            if (__builtin_expect(redo, 0)) {
                softmax_exact(s, mref, negm, t == 0, l_reg, alpha, pa);
                if (__any(alpha[0] < 1.f || alpha[1] < 1.f)) {
#pragma unroll
                    for (int cb = 0; cb < 8; ++cb)
#pragma unroll
                        for (int r = 0; r < 4; ++r) { o[cb][0][r] *= alpha[0]; o[cb][1][r] *= alpha[1]; } } }
            SBAR();
            pv_tile(o, vb00 + sl, pa);
        }
        ATT_STEP_BAR(t);
        sl = (sl == (NSLOT - 1) * SLOTB) ? 0 : sl + SLOTB;
    }
#undef ATT_STEP_BAR
    if (young) __builtin_amdgcn_s_setprio(0);
#pragma unroll
    for (int qb = 0; qb < 2; ++qb) {
        float l = l_reg[qb]; l += __shfl_xor(l, 16); l += __shfl_xor(l, 32);
        const float rl = __builtin_amdgcn_rcpf(l);
        bf16_t* Ow = O + (size_t)(rowbase + q0 + wid * 32 + 16 * qb + l15) * DM + h * DV + 4 * g;
#pragma unroll
        for (int cb = 0; cb < 8; ++cb) { v2u w = {cvt_pk(o[cb][qb][0] * rl, o[cb][qb][1] * rl), cvt_pk(o[cb][qb][2] * rl, o[cb][qb][3] * rl)}; *(v2u*)(Ow + 16 * cb) = w; }
    }
    asm volatile("s_waitcnt lgkmcnt(0)\n\ts_barrier" ::: "memory");
#undef DMA_TILE
}
#undef SBAR
#undef ATT_WAIT_BAR
#undef MFMA16
}

#define XB_TMO      128
#define XB_XCNT(j)  (256  + 64 * (j))
#define XB_XSUB(j)  (1280 + 64 * (j))
#define XB_XGEN(j)  (2304 + 64 * (j))
#define XB_TOP      3328
#define XB_TOPGEN   3392
#define XCD_BAR_WORDS 3456
#define XB_SPIN_CAP (1u << 18)
__device__ __forceinline__ unsigned xb_ld(unsigned* p)              { return __hip_atomic_load(p, __ATOMIC_RELAXED, __HIP_MEMORY_SCOPE_AGENT); }
__device__ __forceinline__ unsigned xb_add(unsigned* p, unsigned v) { return __hip_atomic_fetch_add(p, v, __ATOMIC_RELAXED, __HIP_MEMORY_SCOPE_AGENT); }
__device__ __forceinline__ unsigned xb_xcc_id() { return (unsigned)__builtin_amdgcn_s_getreg((3 << 11) | 20) & 0xFu; }
#define XB_SPIN(cond, bar) do { unsigned _sp = 0; while (cond) { __builtin_amdgcn_s_sleep(1); \
    if ((++_sp & 255u) == 0u) { if (xb_ld(&(bar)[XB_TMO])) break; if (_sp > XB_SPIN_CAP) { atomicAdd(&(bar)[XB_TMO], 1u); break; } } } } while (0)
struct XcdBarrier { unsigned* bar; unsigned x; volatile LAS unsigned* st; };
__device__ __forceinline__ XcdBarrier xcd_barrier_post(unsigned* bar, volatile LAS unsigned* st) {
    XcdBarrier b; b.bar = bar; b.x = (unsigned)__builtin_amdgcn_readfirstlane((int)xb_xcc_id()); b.st = st;
    if (threadIdx.x == 0) (void)xb_add(&bar[XB_XCNT(b.x)], 1u);
    return b;
}
__device__ __forceinline__ void xcd_barrier_complete(unsigned* bar, unsigned x, unsigned& nloc, unsigned& nx) {
    const unsigned G = gridDim.x * gridDim.y * gridDim.z;
    unsigned sum, cnt, mine, sp = 0u;
    for (;;) {
        sum = 0u; cnt = 0u; mine = 0u;
#pragma unroll
        for (unsigned j = 0; j < 16; ++j) { const unsigned c = xb_ld(&bar[XB_XCNT(j)]); sum += c; cnt += (c > 0u) ? 1u : 0u; mine = (j == x) ? c : mine; }
        if (sum == G) break;
        __builtin_amdgcn_s_sleep(1);
        if ((++sp & 255u) == 0u) { if (xb_ld(&bar[XB_TMO])) break; if (sp > XB_SPIN_CAP) { atomicAdd(&bar[XB_TMO], 1u); break; } }
    }
    nloc = mine > 0u ? mine : 1u; nx = cnt > 0u ? cnt : 1u;
}
__device__ __forceinline__ void xcd_barrier(const XcdBarrier& b) {
    asm volatile("s_waitcnt vmcnt(0)" ::: "memory");
    __syncthreads();
    if (threadIdx.x == 0) {
        unsigned* bar = b.bar;
        __builtin_amdgcn_s_waitcnt(0);
        unsigned nloc = b.st[0], nx = b.st[1];
        if (nloc == 0u) { xcd_barrier_complete(bar, b.x, nloc, nx); b.st[0] = nloc; b.st[1] = nx; }
        const unsigned old = xb_add(&bar[XB_XSUB(b.x)], 1u);
        const unsigned gen = old / nloc;
        if (old + 1u == (gen + 1u) * nloc) {
            __builtin_amdgcn_fence(__ATOMIC_RELEASE, "agent");
            asm volatile("s_waitcnt vmcnt(0)" ::: "memory");
            const unsigned og = xb_add(&bar[XB_TOP], 1u);
            const unsigned tg = og / nx;
            if (og + 1u == (tg + 1u) * nx) xb_add(&bar[XB_TOPGEN], 1u);
            else XB_SPIN(xb_ld(&bar[XB_TOPGEN]) == tg, bar);
            __builtin_amdgcn_fence(__ATOMIC_ACQUIRE, "agent");
            xb_add(&bar[XB_XGEN(b.x)], 1u);
            asm volatile("s_waitcnt vmcnt(0)" ::: "memory");
        } else {
            XB_SPIN(xb_ld(&bar[XB_XGEN(b.x)]) == gen, bar);
            __builtin_amdgcn_fence(__ATOMIC_ACQUIRE, "agent");
            asm volatile("s_waitcnt vmcnt(0)" ::: "memory");
        }
    }
    __syncthreads();
}

struct Ctx { int tid, lane, wave, gw, NGW, gtid, NT; LAS unsigned char* lds; };
__device__ __forceinline__ Ctx make_ctx(LAS unsigned char* lds) {
    Ctx C; int tid = threadIdx.x; asm volatile("" : "+v"(tid));
    C.tid = tid; C.lane = tid & 63; C.wave = __builtin_amdgcn_readfirstlane(tid >> 6);
    const int G = gridDim.x, bx = blockIdx.x; const int vcu = (G % 8 == 0) ? (bx % 8) * (G / 8) + bx / 8 : bx;
    C.gw = vcu * NWAVES + C.wave; C.NGW = G * NWAVES; C.gtid = vcu * (NWAVES * 64) + tid; C.NT = G * NWAVES * 64; C.lds = lds; return C;
}

__device__ __forceinline__ void transpose_item(const float* W, int ldw, int k0, int n0, bf16_t* WT, int ldk, int row_dst, LAS float* scr, int lane, const float* gain = nullptr) {
#pragma unroll 8
    for (int i = 0; i < 32; ++i) { const int kk = 2 * i + (lane >> 5); scr[kk * 33 + (lane & 31)] = W[(size_t)(k0 + kk) * ldw + n0 + (lane & 31)]; }
    const int c = lane & 7;
    f32x4 g0 = {1.f, 1.f, 1.f, 1.f}, g1 = g0;
    if (gain) { g0 = *(const GAS f32x4*)(gain + k0 + 8 * c); g1 = *(const GAS f32x4*)(gain + k0 + 8 * c + 4); }
    LDS_WAIT(); asm volatile("" ::: "memory");
#pragma unroll
    for (int j = 0; j < 4; ++j) { const int n = (lane >> 3) + 8 * j; const LAS float* s = scr + (8 * c) * 33 + n;
        v4u o; o.x = pk2(s[0 * 33] * g0.x, s[1 * 33] * g0.y); o.y = pk2(s[2 * 33] * g0.z, s[3 * 33] * g0.w); o.z = pk2(s[4 * 33] * g1.x, s[5 * 33] * g1.y); o.w = pk2(s[6 * 33] * g1.z, s[7 * 33] * g1.w);
        *(GAS v4u*)(WT + (size_t)(row_dst + n) * ldk + k0 + 8 * c) = o; }
    LDS_WAIT(); asm volatile("" ::: "memory");
}
struct WSrc { const float *w_in, *w_q, *w_kv, *pool_w, *w_out, *w_gate, *w_up, *w_down, *g_mix, *g_ffn; };
__device__ __forceinline__ void convert_weights(LAS unsigned char* lds_, const WSrc& S, unsigned char* wl) {
    const Ctx C = make_ctx(lds_);
    LAS float* scr = (LAS float*)(C.lds + C.wave * 16384);
    constexpr int I_IN = (DM / 64) * (IN_DIM / 32), I_Q = (QLR / 64) * (QW / 32), I_KV = (KVLR / 64) * (KVW / 32), I_P = 4 * (PGD / 64) * (PGD / 32), I_O = (DM / 64) * (DM / 32),
                  I_G = (DM / 64) * (DFF / 32), I_D = (DFF / 64) * (DM / 32);
    constexpr int NITEMS = I_IN + I_Q + I_KV + I_P + I_O + 2 * I_G + I_D;
    bf16_t* t_in = (bf16_t*)(wl + WO_IN); bf16_t* t_q = (bf16_t*)(wl + WO_Q); bf16_t* t_kv = (bf16_t*)(wl + WO_KV); bf16_t* t_p = (bf16_t*)(wl + WO_POOL);
    bf16_t* t_o = (bf16_t*)(wl + WO_OUT); bf16_t* t_gu = (bf16_t*)(wl + WO_GU); bf16_t* t_dn = (bf16_t*)(wl + WO_DN);
    for (int it = C.gw; it < NITEMS; it += C.NGW) {
        int r = it;
        if (r < I_IN) { const int nb = IN_DIM / 32, kb = r / nb, n0 = (r % nb) * 32; transpose_item(S.w_in, IN_DIM, kb * 64, n0, t_in, DM, n0, scr, C.lane, S.g_mix); continue; } r -= I_IN;
        if (r < I_Q) { const int nb = QW / 32, kb = r / nb, n0 = (r % nb) * 32; transpose_item(S.w_q, QW, kb * 64, n0, t_q, QLR, n0, scr, C.lane); continue; } r -= I_Q;
        if (r < I_KV) { const int nb = KVW / 32, kb = r / nb, n0 = (r % nb) * 32; transpose_item(S.w_kv, KVW, kb * 64, n0, t_kv, KVLR, n0, scr, C.lane); continue; } r -= I_KV;
        if (r < I_P) { const int per = (PGD / 64) * (PGD / 32), gi = r / per, rr = r % per, nb = PGD / 32, kb = rr / nb, n0 = (rr % nb) * 32;
            transpose_item(S.pool_w + (size_t)gi * PGD * PGD, PGD, kb * 64, n0, t_p, PGD, gi * PGD + n0, scr, C.lane); continue; } r -= I_P;
        if (r < I_O) { const int nb = DM / 32, kb = r / nb, n0 = (r % nb) * 32; transpose_item(S.w_out, DM, kb * 64, n0, t_o, DM, n0, scr, C.lane); continue; } r -= I_O;
        if (r < I_G) { const int nb = DFF / 32, kb = r / nb, n0 = (r % nb) * 32; transpose_item(S.w_gate, DFF, kb * 64, n0, t_gu, DM, 256 * (n0 >> 7) + (n0 & 127), scr, C.lane, S.g_ffn); continue; } r -= I_G;
        if (r < I_G) { const int nb = DFF / 32, kb = r / nb, n0 = (r % nb) * 32; transpose_item(S.w_up, DFF, kb * 64, n0, t_gu, DM, 256 * (n0 >> 7) + 128 + (n0 & 127), scr, C.lane, S.g_ffn); continue; } r -= I_G;
        { const int nb = DM / 32, kb = r / nb, n0 = (r % nb) * 32; transpose_item(S.w_down, DM, kb * 64, n0, t_dn, DFF, n0, scr, C.lane); }
    }
    { v4u* p = (v4u*)(t_in + (size_t)IN_DIM * DM); const int n16 = (IN_PAD - IN_DIM) * DM * 2 / 16; for (int i = C.gtid; i < n16; i += C.NT) p[i] = (v4u){0u, 0u, 0u, 0u}; }
}
__device__ __forceinline__ void rope_table(LAS unsigned char* lds_, const int* pos, float* tab) {
    const Ctx C = make_ctx(lds_);
    for (int it = C.gtid; it < M * 32; it += C.NT) { const int m = it >> 5, i = it & 31;
        const float inv = powf(10000.0f, -(float)(2 * i) / 64.0f); const float ang = (float)pos[m] * inv;
        float s, c; sincosf(ang, &s, &c); tab[(size_t)m * 64 + i] = c; tab[(size_t)m * 64 + 32 + i] = s; }
}
__device__ __forceinline__ void xcopy_first(LAS unsigned char* lds_, const float* x, bf16_t* hb, float* rs) {
    const Ctx C = make_ctx(lds_);
    for (int m = C.gw; m < M; m += C.NGW) {
        const GAS f32x4* xr = (const GAS f32x4*)(x + (size_t)m * DM) + C.lane;
        f32x4 v[16]; float ss = 0.f;
#pragma unroll
        for (int j = 0; j < 16; ++j) { v[j] = xr[64 * j]; ss += (v[j].x * v[j].x + v[j].y * v[j].y) + (v[j].z * v[j].z + v[j].w * v[j].w); }
        ss = wave_sum(ss);
        if (C.lane == 0) rs[m] = rsqrtf(ss * (1.f / DM) + EPS);
        GAS v2u* o8 = (GAS v2u*)(hb + (size_t)m * DM) + C.lane;
#pragma unroll
        for (int j = 0; j < 16; ++j) { v2u w; w.x = pk2(v[j].x, v[j].y); w.y = pk2(v[j].z, v[j].w); o8[64 * j] = w; }
    }
}
template <bool HIN_F32, bool OUT_F32>
__device__ __forceinline__ void resnorm(LAS unsigned char* lds_, const bf16_t* mb, const void* hin_, const float* gpost, bf16_t* hb_out, float* outf, float* rs) {
    const Ctx C = make_ctx(lds_);
    for (int m = C.gw; m < M; m += C.NGW) {
        const GAS v4u* mr = (const GAS v4u*)(mb + (size_t)m * DM) + C.lane;
        v4u mw[8]; float ss = 0.f;
#pragma unroll
        for (int j = 0; j < 8; ++j) { mw[j] = mr[64 * j];
#pragma unroll
            for (int e = 0; e < 4; ++e) { const float lo = bflo(mw[j][e]), hi = bfhi(mw[j][e]); ss += lo * lo + hi * hi; } }
        const float rstd = rsqrtf(wave_sum(ss) * (1.f / DM) + EPS);
        float s2 = 0.f;
#pragma unroll
        for (int j = 0; j < 8; ++j) {
            const size_t col = (size_t)8 * (C.lane + 64 * j);
            f32x4 h0, h1;
            if constexpr (HIN_F32) { const float* hin = (const float*)hin_; h0 = *(const GAS f32x4*)(hin + (size_t)m * DM + col); h1 = *(const GAS f32x4*)(hin + (size_t)m * DM + col + 4); }
            else { const v4u hw = *(const GAS v4u*)((const bf16_t*)hin_ + (size_t)m * DM + col);
                   h0 = (f32x4){bflo(hw[0]), bfhi(hw[0]), bflo(hw[1]), bfhi(hw[1])}; h1 = (f32x4){bflo(hw[2]), bfhi(hw[2]), bflo(hw[3]), bfhi(hw[3])}; }
            const f32x4 g0 = *(const GAS f32x4*)(gpost + col), g1 = *(const GAS f32x4*)(gpost + col + 4);
            f32x4 a0, a1;
            a0.x = h0.x + bflo(mw[j][0]) * rstd * g0.x; a0.y = h0.y + bfhi(mw[j][0]) * rstd * g0.y; a0.z = h0.z + bflo(mw[j][1]) * rstd * g0.z; a0.w = h0.w + bfhi(mw[j][1]) * rstd * g0.w;
            a1.x = h1.x + bflo(mw[j][2]) * rstd * g1.x; a1.y = h1.y + bfhi(mw[j][2]) * rstd * g1.y; a1.z = h1.z + bflo(mw[j][3]) * rstd * g1.z; a1.w = h1.w + bfhi(mw[j][3]) * rstd * g1.w;
            if constexpr (OUT_F32) { *(GAS f32x4*)(outf + (size_t)m * DM + col) = a0; *(GAS f32x4*)(outf + (size_t)m * DM + col + 4) = a1; }
            else { s2 += (a0.x * a0.x + a0.y * a0.y) + (a0.z * a0.z + a0.w * a0.w) + (a1.x * a1.x + a1.y * a1.y) + (a1.z * a1.z + a1.w * a1.w);
                   v4u w; w.x = pk2(a0.x, a0.y); w.y = pk2(a0.z, a0.w); w.z = pk2(a1.x, a1.y); w.w = pk2(a1.z, a1.w);
                   *(GAS v4u*)(hb_out + (size_t)m * DM + col) = w; }
        }
        if constexpr (!OUT_F32) { s2 = wave_sum(s2); if (C.lane == 0) rs[m] = rsqrtf(s2 * (1.f / DM) + EPS); }
    }
}
template <int W> __device__ __forceinline__ void pool_block(const bf16_t* up0, int sq0, bf16_t* dp0) {
    v4u v[W + 3];
#pragma unroll
    for (int i = 0; i < W + 3; ++i) { const int rel = i - (W - 1); const int off = (sq0 + rel >= 0) ? rel : 0; v[i] = *(const GAS v4u*)(up0 + (long)off * IN_PAD); }
    float S[8];
#pragma unroll
    for (int e = 0; e < 8; ++e) S[e] = 0.f;
#pragma unroll
    for (int i = 0; i < W; ++i) { const float wi = (sq0 + i - (W - 1) >= 0) ? 1.f : 0.f;
#pragma unroll
        for (int e = 0; e < 4; ++e) { S[2 * e] += wi * bflo(v[i][e]); S[2 * e + 1] += wi * bfhi(v[i][e]); } }
#pragma unroll
    for (int t = 0; t < 4; ++t) {
        if (t > 0) { const float wo = (sq0 + (t - 1) - (W - 1) >= 0) ? 1.f : 0.f;
#pragma unroll
            for (int e = 0; e < 4; ++e) { S[2 * e] += bflo(v[W - 1 + t][e]) - wo * bflo(v[t - 1][e]); S[2 * e + 1] += bfhi(v[W - 1 + t][e]) - wo * bfhi(v[t - 1][e]); } }
        const int cnt = (sq0 + t + 1) < W ? (sq0 + t + 1) : W; const float inv = 1.0f / (float)cnt;
        v4u o;
#pragma unroll
        for (int e = 0; e < 4; ++e) o[e] = pk2(S[2 * e] * inv - bflo(v[W - 1 + t][e]), S[2 * e + 1] * inv - bfhi(v[W - 1 + t][e]));
        *(GAS v4u*)(dp0 + (size_t)t * POOLW) = o;
    }
}
__device__ __forceinline__ float sumsq8(const v4u w) { float s = 0.f;
#pragma unroll
    for (int e = 0; e < 4; ++e) { const float lo = bflo(w[e]), hi = bfhi(w[e]); s += lo * lo + hi * hi; } return s; }
__device__ __forceinline__ v4u scale8(const v4u w, float r, const f32x4 g0, const f32x4 g1) {
    v4u o; o.x = pk2(bflo(w[0]) * r * g0.x, bfhi(w[0]) * r * g0.y); o.y = pk2(bflo(w[1]) * r * g0.z, bfhi(w[1]) * r * g0.w);
    o.z = pk2(bflo(w[2]) * r * g1.x, bfhi(w[2]) * r * g1.y); o.w = pk2(bflo(w[3]) * r * g1.z, bfhi(w[3]) * r * g1.w); return o; }
__device__ __forceinline__ void mixer_prep(LAS unsigned char* lds_, const bf16_t* z, const float* qn, const float* kvn, const float* tab, bf16_t* cqn, bf16_t* ckvn, unsigned char* rimg, bf16_t* dp) {
    const Ctx C = make_ctx(lds_);
    {
        const int l = C.lane; const bool two = l < 48;
        const f32x4 gq0 = *(const GAS f32x4*)(qn + 8 * l), gq1 = *(const GAS f32x4*)(qn + 8 * l + 4);
        const f32x4 gr0 = two ? *(const GAS f32x4*)(qn + 512 + 8 * l) : (f32x4){0.f, 0.f, 0.f, 0.f}, gr1 = two ? *(const GAS f32x4*)(qn + 512 + 8 * l + 4) : (f32x4){0.f, 0.f, 0.f, 0.f};
        const f32x4 gk0 = *(const GAS f32x4*)(kvn + 8 * l), gk1 = *(const GAS f32x4*)(kvn + 8 * l + 4);
        for (int m = C.gw; m < M; m += C.NGW) {
            const bf16_t* zr = z + (size_t)m * IN_PAD;
            const v4u q0 = *(const GAS v4u*)(zr + OQ + 8 * l);
            const v4u q1 = two ? *(const GAS v4u*)(zr + OQ + 512 + 8 * l) : (v4u){0u, 0u, 0u, 0u};
            const v4u kv = *(const GAS v4u*)(zr + OKV + 8 * l);
            const int i = l & 31, which = l >> 5;
            const float t1 = bf2f(zr[OROPE + i]), t2 = bf2f(zr[OROPE + 32 + i]), c = tab[(size_t)m * 64 + i], s = tab[(size_t)m * 64 + 32 + i];
            float sq_ = sumsq8(q0) + sumsq8(q1), sk_ = sumsq8(kv);
#pragma unroll
            for (int o = 1; o < 64; o <<= 1) { sq_ += __shfl_xor(sq_, o); sk_ += __shfl_xor(sk_, o); }
            const float rq = rsqrtf(sq_ * (1.f / QLR) + EPS), rk = rsqrtf(sk_ * (1.f / KVLR) + EPS);
            *(GAS v4u*)(cqn + (size_t)m * QLR + 8 * l) = scale8(q0, rq, gq0, gq1);
            if (two) *(GAS v4u*)(cqn + (size_t)m * QLR + 512 + 8 * l) = scale8(q1, rq, gr0, gr1);
            *(GAS v4u*)(ckvn + (size_t)m * KVLR + 8 * l) = scale8(kv, rk, gk0, gk1);
            const float r = which ? (t2 * c + t1 * s) : (t1 * c - t2 * s); const int d = i + 32 * which;
            const int bb = m >> 13, sq = m & (SEQ - 1), T = sq >> 6, k = sq & 63;
            *(bf16_t*)(rimg + (size_t)(bb * 128 + T) * 8192 + (d >> 3) * 1024 + k * 16 + (d & 7) * 2) = (bf16_t)f2bf(r);
        }
    }
    for (int it = C.gtid; it < (M / 4) * 256; it += C.NT) {
        const int rb = it >> 8, ch = it & 255, g = ch >> 6, r0 = 4 * rb, sq0 = r0 & (SEQ - 1);
        const bf16_t* up0 = z + (size_t)r0 * IN_PAD + OU + ch * 8; bf16_t* dp0 = dp + (size_t)r0 * POOLW + ch * 8;
        if (g == 0) pool_block<2>(up0, sq0, dp0); else if (g == 1) pool_block<4>(up0, sq0, dp0); else if (g == 2) pool_block<8>(up0, sq0, dp0); else pool_block<16>(up0, sq0, dp0);
    }
}

#ifndef ATT_REP
#define ATT_REP 1
#endif
#ifdef NO_THIN
#define THIN_CALL if (0)
#else
#define THIN_CALL
#endif
#ifdef NO_GEMM
#define GEMM_CALL if (0)
#else
#define GEMM_CALL
#endif
struct Args { const float* in[17]; float* out; unsigned char* ws; };
typedef const __attribute__((address_space(4))) Args* KArgs;
__device__ __forceinline__ KArgs kargs() { KArgs p = (KArgs)__builtin_amdgcn_kernarg_segment_ptr(); asm volatile("" : "+s"(p)); return p; }
#define KIN(k) ((const float*)kargs()->in[k])
__global__ void __launch_bounds__(NWAVES * 64, 2) fwd_kernel(Args args) {
    extern __shared__ __attribute__((aligned(16))) unsigned char lds_raw[];
    LAS unsigned char* lds = (LAS unsigned char*)lds_raw;
    const int G = gridDim.x, bx = blockIdx.x; const int vcu = (G % 8 == 0) ? (bx % 8) * (G / 8) + bx / 8 : bx;
    unsigned char* ws = kargs()->ws;
    unsigned* ctl = (unsigned*)(ws + WS_CTL);
    for (int u = threadIdx.x; u < (LDS_BYTES - LDSCTL_OFF) / 4; u += NWAVES * 64) ((LAS unsigned*)(lds + LDSCTL_OFF))[u] = 0u;
    __syncthreads();
    volatile LAS unsigned* MISC = (volatile LAS unsigned*)(lds + MISC_OFF);
    (void)xcd_barrier_post(ctl + CW_BAR, MISC + 8);

#define WSP(off) (kargs()->ws + (off))
#define GRID_BARRIER() do { XcdBarrier b_; b_.bar = (unsigned*)WSP(WS_CTL) + CW_BAR; b_.x = (unsigned)__builtin_amdgcn_readfirstlane((int)xb_xcc_id()); \
        b_.st = (volatile LAS unsigned*)(lds + MISC_OFF) + 8; xcd_barrier(b_); } while (0)
#define tab  ((float*)WSP(WS_ROPE))
#define RS   ((float*)WSP(WS_RS))
#define A    ((bf16_t*)WSP(WS_A))
#define MB   ((bf16_t*)WSP(WS_MB))
#define ACT  ((bf16_t*)WSP(WS_ACT))
#define Z    ((bf16_t*)WSP(WS_Z))
#define CQN  ((bf16_t*)WSP(WS_CQN))
#define CKVN ((bf16_t*)WSP(WS_CKVN))
#define RIMG (WSP(WS_KROPE))
#define DP   ((bf16_t*)WSP(WS_DP))
#define Q    ((bf16_t*)WSP(WS_Q))
#define KIMG (WSP(WS_KIMG))
#define VIMG (WSP(WS_VIMG))
#define CAT  ((bf16_t*)WSP(WS_CAT))
#pragma unroll 1
    for (int l = 0; l < 2; ++l) {
        WSrc S; S.w_in = KIN(2) + (size_t)l * DM * IN_DIM; S.w_q = KIN(4) + (size_t)l * QLR * QW; S.w_kv = KIN(6) + (size_t)l * KVLR * KVW; S.pool_w = KIN(7) + (size_t)l * 4 * PGD * PGD;
        S.w_out = KIN(9) + (size_t)l * DM * DM; S.w_gate = KIN(14) + (size_t)l * DM * DFF; S.w_up = KIN(15) + (size_t)l * DM * DFF; S.w_down = KIN(16) + (size_t)l * DFF * DM; S.g_mix = KIN(10) + (size_t)l * DM; S.g_ffn = KIN(12) + (size_t)l * DM;
        THIN_CALL convert_weights(lds, S, WSP(WS_W0) + (size_t)l * W_LAYER);
    }
    THIN_CALL rope_table(lds, (const int*)KIN(1), tab);
    THIN_CALL xcopy_first(lds, KIN(0), A, RS);
    GRID_BARRIER();

#pragma unroll 1
    for (int l = 0; l < 2; ++l) {
#define wl (WSP(WS_W0) + (size_t)l * W_LAYER)
        { pg8::Gemm g{A, (const bf16_t*)(wl + WO_IN), M, IN_PAD, DM, DM, 0}; pg8::StaticOrder S; S.init(M, IN_PAD, G, bx);
          pg8::EpiStore E{Z, IN_PAD, 1.0f, RS}; GEMM_CALL pg8::gemm_phase<pg8::EpiStore>(lds, g, S, E); }
        GRID_BARRIER();
        THIN_CALL mixer_prep(lds, Z, KIN(3) + (size_t)l * QLR, KIN(5) + (size_t)l * KVLR, tab, CQN, CKVN, RIMG, DP);
        GRID_BARRIER();
        { pg8::Gemm g{DP, (const bf16_t*)(wl + WO_POOL), M, POOLW, PGD, POOLW, PGD}; pg8::StaticOrder S; S.init(M, POOLW, G, bx);
          pg8::EpiPool E{CAT, KIN(8) + (size_t)l * POOLW}; GEMM_CALL pg8::gemm_phase<pg8::EpiPool>(lds, g, S, E); }
        { pg8::Gemm g{CQN, (const bf16_t*)(wl + WO_Q), M, QW, QLR, QLR, 0}; pg8::StaticOrder S; S.init(M, QW, G, bx);
          pg8::EpiStore E{Q, QW, QSCALE, nullptr}; GEMM_CALL pg8::gemm_phase<pg8::EpiStore>(lds, g, S, E); }
        { pg8::Gemm g{CKVN, (const bf16_t*)(wl + WO_KV), M, KVW, KVLR, KVLR, 0}; pg8::StaticOrder S; S.init(M, KVW, G, bx);
          pg8::EpiKV E{KIMG, VIMG}; GEMM_CALL pg8::gemm_phase<pg8::EpiKV>(lds, g, S, E); }
        GRID_BARRIER();
#ifndef NO_ATT
        {
            if (G == 256) { const int s = vcu & 15, h = vcu >> 4;
#pragma unroll 1
                for (int i = 0; i < 4 * ATT_REP; ++i) { const int qb = (i & 1) ? s : 31 - s;
                    att::attn_unit((i >> 1) & 1, h, qb, Q, KIMG, VIMG, RIMG, tab, CAT, lds); } }
            else {
#pragma unroll 1
                for (int L = bx; L < BATCH * NH * 32; L += G) { const int bh = L >> 5, qb = 31 - (L & 31); att::attn_unit(bh >> 4, bh & 15, qb, Q, KIMG, VIMG, RIMG, tab, CAT, lds); } }
        }
#endif
        GRID_BARRIER();
        { pg8::Gemm g{CAT, (const bf16_t*)(wl + WO_OUT), M, DM, DM, DM, 0}; pg8::StaticOrder S; S.init(M, DM, G, bx);
          pg8::EpiStore E{MB, DM, 1.0f, nullptr}; GEMM_CALL pg8::gemm_phase<pg8::EpiStore>(lds, g, S, E); }
        GRID_BARRIER();
        if (l == 0) { THIN_CALL resnorm<true, false>(lds, MB, KIN(0), KIN(11), A, nullptr, RS); }
        else { THIN_CALL resnorm<false, false>(lds, MB, A, KIN(11) + DM, A, nullptr, RS); }
        GRID_BARRIER();
        { pg8::Gemm g{A, (const bf16_t*)(wl + WO_GU), M, 2 * DFF, DM, DM, 0}; pg8::StaticOrder S; S.init(M, 2 * DFF, G, bx); S.rev = 1;
          pg8::EpiSwiGLU E{ACT, RS}; GEMM_CALL pg8::gemm_phase<pg8::EpiSwiGLU>(lds, g, S, E); }
        GRID_BARRIER();
        { pg8::Gemm g{ACT, (const bf16_t*)(wl + WO_DN), M, DM, DFF, DFF, 0}; pg8::StaticOrder S; S.init(M, DM, G, bx, 4); S.pair = (G == 256) ? 1 : 0;
          pg8::EpiStore E{MB, DM, 1.0f, nullptr}; GEMM_CALL pg8::gemm_phase<pg8::EpiStore>(lds, g, S, E); }
        GRID_BARRIER();
        if (l == 0) { THIN_CALL resnorm<false, false>(lds, MB, A, KIN(13), A, nullptr, RS); }
        else { THIN_CALL resnorm<false, true>(lds, MB, A, KIN(13) + DM, nullptr, kargs()->out, nullptr); }
        if (l == 0) GRID_BARRIER();
    }
}

#undef WSP
#undef tab
#undef RS
#undef A
#undef MB
#undef ACT
#undef Z
#undef CQN
#undef CKVN
#undef RIMG
#undef DP
#undef Q
#undef KIMG
#undef VIMG
#undef CAT
#undef wl
extern "C" void kernel_launch(void* const* d_in, const int* in_sizes, int n_in, void* d_out, int out_size, void* d_ws, size_t ws_size, hipStream_t stream) {
    static int grid = 0;
    if (grid == 0) {
        if (n_in != 17 || out_size != M * DM || ws_size < WS_END) { fprintf(stderr, "kernel_launch: unexpected shapes (n_in %d, out %d, ws %zu; need ws >= %zu)\n", n_in, out_size, ws_size, (size_t)WS_END); grid = -1; return; }
        int dev = 0, cus = 0, per_cu = 0;
        if (hipGetDevice(&dev) != hipSuccess || hipDeviceGetAttribute(&cus, hipDeviceAttributeMultiprocessorCount, dev) != hipSuccess) { grid = -1; return; }
        if (hipFuncSetAttribute((const void*)fwd_kernel, hipFuncAttributeMaxDynamicSharedMemorySize, LDS_BYTES) != hipSuccess) { fprintf(stderr, "kernel_launch: hipFuncSetAttribute failed\n"); grid = -1; return; }
        if (hipOccupancyMaxActiveBlocksPerMultiprocessor(&per_cu, (const void*)fwd_kernel, NWAVES * 64, LDS_BYTES) != hipSuccess || per_cu < 1)
            fprintf(stderr, "kernel_launch: note: occupancy query reports %d workgroups per CU\n", per_cu);
        (void)hipGetLastError();
        grid = cus;
    }
    if (grid < 0) return;
    (void)in_sizes;
    if (hipMemsetAsync((char*)d_ws + WS_CTL, 0, CTL_ZERO_BYTES, stream) != hipSuccess) return;
    Args a{};
    for (int i = 0; i < 17; ++i) a.in[i] = (const float*)d_in[i];
    a.out = (float*)d_out; a.ws = (unsigned char*)d_ws;
    hipLaunchKernelGGL(fwd_kernel, dim3(grid), dim3(NWAVES * 64), LDS_BYTES, stream, a);
    const hipError_t le = hipPeekAtLastError();
    if (le != hipSuccess) fprintf(stderr, "kernel_launch: launch failed: %s\n", hipGetErrorName(le));
}
```
